# Optimizing an MI355X kernel written in HIP

```python
import math
import jax, jax.numpy as jnp
from jax import lax
import numpy as np

D_MODEL = 1024
BATCH = 8
SEQ = 2048
DEPTH = 1
DEC_BATCH = 128
DEC_SEQ = 8
PAST_LEN = 16384
PAGE_SIZE = 128

N_META = 16
SC_WIDTH = D_MODEL
SC_TAPS = 3
GDN_HEADS = 8
GDN_DK = 128
GDN_DV = 128
GDN_KEY = GDN_HEADS * GDN_DK
GDN_VAL = GDN_HEADS * GDN_DV
GDN_QKV = 2 * GDN_KEY + GDN_VAL
GDN_TAPS = 4
GDN_CHUNK = 64
D_FF = 2816
IN_COLS = 3 * SC_WIDTH + GDN_QKV + 2 * GDN_HEADS + GDN_VAL + 2 * D_MODEL
EPS = 1e-6
L2_EPS = 1e-6

kernel_name = 'macaron_gated_shortconv_deltanet_step'


def rmsnorm(x, g):
    xf = x.astype(jnp.float32)
    y = xf * lax.rsqrt(jnp.mean(xf * xf, axis=-1, keepdims=True) + EPS)
    return (y * g.astype(jnp.float32)).astype(x.dtype)


def l2norm(x):
    return x * lax.rsqrt(jnp.sum(x * x, axis=-1, keepdims=True) + L2_EPS)


def swiglu(x, w_gate, w_up, w_down):
    return (jax.nn.silu(x @ w_gate) * (x @ w_up)) @ w_down


def causal_dwconv(x, buf, w):
    taps = w.shape[0]
    l = x.shape[1]
    xp = jnp.concatenate([buf.astype(x.dtype), x], axis=1)
    y = xp[:, 0:l] * w[0]
    for j in range(1, taps):
        y = y + xp[:, j:j + l] * w[j]
    return y, xp[:, l:]


def split_columns(proj):
    sizes = (SC_WIDTH, SC_WIDTH, SC_WIDTH, GDN_QKV, GDN_HEADS, GDN_HEADS, GDN_VAL, D_MODEL, D_MODEL)
    offs = np.cumsum(sizes)[:-1].tolist()
    return jnp.split(proj, offs, axis=-1)


def gdn_chunked(q, k, v, log_a, beta, s0, chunk):
    b, l, h, dk = q.shape
    dv = v.shape[-1]
    n = l // chunk

    def blk(t):
        t = t.reshape((b, n, chunk, h) + t.shape[3:])
        return jnp.moveaxis(t, 3, 2)

    q, k, v, log_a, beta = blk(q), blk(k), blk(v), blk(log_a), blk(beta)
    g = jnp.cumsum(log_a, axis=-1)
    diff = g[..., :, None] - g[..., None, :]
    idx = jnp.arange(chunk)
    strict = idx[:, None] > idx[None, :]
    incl = idx[:, None] >= idx[None, :]
    dec_strict = jnp.exp(jnp.where(strict, diff, -jnp.inf))
    dec_incl = jnp.exp(jnp.where(incl, diff, -jnp.inf))
    a_kk = beta[..., :, None] * jnp.einsum('bnhid,bnhjd->bnhij', k, k) * dec_strict
    rhs = jnp.concatenate([beta[..., None] * v, (beta * jnp.exp(g))[..., None] * k], axis=-1)
    sol = lax.linalg.triangular_solve(a_kk, rhs, left_side=True, lower=True, unit_diagonal=True)
    u, w = sol[..., :dv], sol[..., dv:]
    a_qk = jnp.einsum('bnhid,bnhjd->bnhij', q, k) * dec_incl
    q_dec = q * jnp.exp(g)[..., None]
    g_last = g[..., -1]
    k_dec = k * jnp.exp(g_last[..., None] - g)[..., None]

    def step(s, xs):
        u_c, w_c, aqk_c, qd_c, kd_c, gl_c = xs
        nu = u_c - jnp.einsum('bhcd,bhde->bhce', w_c, s)
        o = jnp.einsum('bhcd,bhde->bhce', qd_c, s) + jnp.einsum('bhij,bhje->bhie', aqk_c, nu)
        s = jnp.exp(gl_c)[..., None, None] * s + jnp.einsum('bhcd,bhce->bhde', kd_c, nu)
        return s, o

    xs = tuple(jnp.moveaxis(t, 1, 0) for t in (u, w, a_qk, q_dec, k_dec, g_last))
    s_fin, o = lax.scan(step, s0, xs)
    o = jnp.transpose(o, (1, 0, 3, 2, 4)).reshape(b, l, h, dv)
    return o, s_fin


def gdn_mixer(qkv_pre, a_raw, b_raw, z, conv_buf, s0, conv_w, a_log, dt_bias, norm_g, segments):
    bsz, l, _ = qkv_pre.shape
    f32 = jnp.float32
    qkv, conv_buf = causal_dwconv(qkv_pre, conv_buf, conv_w)
    qkv = jax.nn.silu(qkv).astype(f32)
    q, k, v = jnp.split(qkv, [GDN_KEY, 2 * GDN_KEY], axis=-1)
    q = l2norm(q.reshape(bsz, l, GDN_HEADS, GDN_DK)) * (GDN_DK ** -0.5)
    k = l2norm(k.reshape(bsz, l, GDN_HEADS, GDN_DK))
    v = v.reshape(bsz, l, GDN_HEADS, GDN_DV)
    beta = jax.nn.sigmoid(b_raw.astype(f32))
    log_a = -jnp.exp(a_log.astype(f32)) * jax.nn.softplus(a_raw.astype(f32) + dt_bias.astype(f32))
    s = s0.astype(f32)
    outs = []
    start = 0
    for seg_len, chunk in segments:
        sl = slice(start, start + seg_len)
        o_seg, s = gdn_chunked(q[:, sl], k[:, sl], v[:, sl], log_a[:, sl], beta[:, sl], s, chunk)
        outs.append(o_seg)
        start += seg_len
    o = jnp.concatenate(outs, axis=1)
    zh = z.astype(f32).reshape(bsz, l, GDN_HEADS, GDN_DV)
    o = rmsnorm(o, norm_g) * jax.nn.silu(zh)
    return o.reshape(bsz, l, GDN_VAL).astype(qkv_pre.dtype), conv_buf, s.astype(s0.dtype)


def layer(x, sc_buf, gdn_buf, gdn_s, segments, w):
    (n_f1, f1_g, f1_u, f1_d, n_mix, w_in, sc_w, gc_w, a_log, dt_bias, g_norm,
     w_a, w_b, w_o, n_f2, f2_g, f2_u, f2_d) = w
    x = x + 0.5 * swiglu(rmsnorm(x, n_f1), f1_g, f1_u, f1_d)
    h = rmsnorm(x, n_mix)
    proj = h @ w_in
    sc_b, sc_c, sc_x, qkv_pre, a_raw, b_raw, z, gate_a, gate_b = split_columns(proj)
    conv_out, sc_buf = causal_dwconv(sc_c * sc_x, sc_buf, sc_w)
    y_a = sc_b * conv_out
    y_b, gdn_buf, gdn_s = gdn_mixer(qkv_pre, a_raw, b_raw, z, gdn_buf, gdn_s, gc_w,
                                    a_log, dt_bias, g_norm, segments)
    merged = jax.nn.sigmoid(gate_a) * (y_a @ w_a) + jax.nn.sigmoid(gate_b) * (y_b @ w_b)
    x = x + merged @ w_o
    x = x + 0.5 * swiglu(rmsnorm(x, n_f2), f2_g, f2_u, f2_d)
    return x, sc_buf, gdn_buf, gdn_s


def trunk(x, sc_bufs, gdn_bufs, gdn_states, segments, weights, norm_final):
    new_sc, new_gc, new_gs = [], [], []
    for i in range(DEPTH):
        x, sc, gc, gs = layer(x, sc_bufs[i], gdn_bufs[i], gdn_states[i], segments,
                              tuple(wt[i] for wt in weights))
        new_sc.append(sc)
        new_gc.append(gc)
        new_gs.append(gs)
    return rmsnorm(x, norm_final), jnp.stack(new_sc), jnp.stack(new_gc), jnp.stack(new_gs)


def setup_inputs(seed: int = 0) -> dict:
    key = jax.random.key(seed)
    ks = jax.random.split(key, 32)
    f32 = jnp.float32

    def nrm(k, shape, scale):
        return jax.random.normal(k, shape, f32) * scale

    def gain(k, shape):
        return 1.0 + 0.02 * jax.random.normal(k, shape, f32)

    dt = jnp.exp(jax.random.uniform(ks[14], (DEPTH, GDN_HEADS), f32, math.log(1e-3), math.log(1e-1)))
    dt_bias = dt + jnp.log(-jnp.expm1(-dt))
    a_log = jnp.log(jax.random.uniform(ks[13], (DEPTH, GDN_HEADS), f32, 1.0, 16.0))
    return {
        'x_prompt': nrm(ks[0], (BATCH, SEQ, D_MODEL), 1.0),
        'x_sample': nrm(ks[1], (DEC_BATCH, DEC_SEQ, D_MODEL), 1.0),
        'state_sconv': nrm(ks[2], (DEPTH, DEC_BATCH, SC_TAPS - 1, SC_WIDTH), 1.0),
        'state_gdn_conv': nrm(ks[3], (DEPTH, DEC_BATCH, GDN_TAPS - 1, GDN_QKV), 1.0),
        'state_gdn': nrm(ks[4], (DEPTH, DEC_BATCH, GDN_HEADS, GDN_DK, GDN_DV), 0.1),
        'meta_tokens': nrm(ks[5], (N_META, D_MODEL), 1.0),
        'norm_ffn1': gain(ks[6], (DEPTH, D_MODEL)),
        'ffn1_w_gate': nrm(ks[7], (DEPTH, D_MODEL, D_FF), D_MODEL ** -0.5),
        'ffn1_w_up': nrm(ks[8], (DEPTH, D_MODEL, D_FF), D_MODEL ** -0.5),
        'ffn1_w_down': nrm(ks[9], (DEPTH, D_FF, D_MODEL), D_FF ** -0.5),
        'norm_mix': gain(ks[10], (DEPTH, D_MODEL)),
        'w_in': nrm(ks[11], (DEPTH, D_MODEL, IN_COLS), D_MODEL ** -0.5),
        'sconv_w': nrm(ks[12], (DEPTH, SC_TAPS, SC_WIDTH), SC_TAPS ** -0.5),
        'gdn_conv_w': nrm(ks[15], (DEPTH, GDN_TAPS, GDN_QKV), GDN_TAPS ** -0.5),
        'gdn_a_log': a_log,
        'gdn_dt_bias': dt_bias,
        'gdn_norm': gain(ks[16], (DEPTH, GDN_DV)),
        'w_a_out': nrm(ks[17], (DEPTH, SC_WIDTH, D_MODEL), SC_WIDTH ** -0.5),
        'w_b_out': nrm(ks[18], (DEPTH, GDN_VAL, D_MODEL), GDN_VAL ** -0.5),
        'w_o': nrm(ks[19], (DEPTH, D_MODEL, D_MODEL), D_MODEL ** -0.5),
        'norm_ffn2': gain(ks[20], (DEPTH, D_MODEL)),
        'ffn2_w_gate': nrm(ks[21], (DEPTH, D_MODEL, D_FF), D_MODEL ** -0.5),
        'ffn2_w_up': nrm(ks[22], (DEPTH, D_MODEL, D_FF), D_MODEL ** -0.5),
        'ffn2_w_down': nrm(ks[23], (DEPTH, D_FF, D_MODEL), D_FF ** -0.5),
        'norm_final': gain(ks[24], (D_MODEL,)),
    }


def reference(x_prompt, x_sample, state_sconv, state_gdn_conv, state_gdn, meta_tokens,
              norm_ffn1, ffn1_w_gate, ffn1_w_up, ffn1_w_down, norm_mix, w_in, sconv_w,
              gdn_conv_w, gdn_a_log, gdn_dt_bias, gdn_norm, w_a_out, w_b_out, w_o,
              norm_ffn2, ffn2_w_gate, ffn2_w_up, ffn2_w_down, norm_final):
    weights = (norm_ffn1, ffn1_w_gate, ffn1_w_up, ffn1_w_down, norm_mix, w_in, sconv_w,
               gdn_conv_w, gdn_a_log, gdn_dt_bias, gdn_norm, w_a_out, w_b_out, w_o,
               norm_ffn2, ffn2_w_gate, ffn2_w_up, ffn2_w_down)
    bsz, seq = x_prompt.shape[0], x_prompt.shape[1]
    dt = x_prompt.dtype
    meta = jnp.broadcast_to(meta_tokens.astype(dt)[None], (bsz, N_META, D_MODEL))
    xp = jnp.concatenate([meta, x_prompt], axis=1)
    zero_sc = jnp.zeros((DEPTH, bsz, SC_TAPS - 1, SC_WIDTH), dt)
    zero_gc = jnp.zeros((DEPTH, bsz, GDN_TAPS - 1, GDN_QKV), dt)
    zero_gs = jnp.zeros((DEPTH, bsz, GDN_HEADS, GDN_DK, GDN_DV), dt)
    seg_prompt = ((N_META, N_META), (seq, GDN_CHUNK))
    yp, p_sc, p_gc, p_gs = trunk(xp, zero_sc, zero_gc, zero_gs, seg_prompt, weights, norm_final)
    y_prompt = yp[:, N_META:]
    dec_len = x_sample.shape[1]
    seg_sample = ((dec_len, dec_len),)
    y_sample, s_sc, s_gc, s_gs = trunk(x_sample, state_sconv, state_gdn_conv, state_gdn,
                                       seg_sample, weights, norm_final)
    return (y_prompt, y_sample, p_sc, p_gc, p_gs, s_sc, s_gc, s_gs)
```

```cpp
#include <hip/hip_runtime.h>
#include <hip/hip_cooperative_groups.h>
#include <cstdio>
#include <cstdint>
namespace cg = cooperative_groups;

#ifndef PROBE
#define PROBE 0
#endif
#ifndef ONE_LAUNCH
#define ONE_LAUNCH 1
#endif

#define LAS __attribute__((address_space(3)))
typedef unsigned short bf16_t;
typedef short bf16x8 __attribute__((ext_vector_type(8)));
typedef float f32x4 __attribute__((ext_vector_type(4)));
typedef unsigned u32x4 __attribute__((ext_vector_type(4)));
typedef unsigned u32x2 __attribute__((ext_vector_type(2)));

constexpr int TP = 17664, TREAL = 17536, ROW_SAMPLE = 16384, ROW_META = 17408;
constexpr int D = 1024, FF = 2816, INC = 9232;
constexpr int NITEM_P = 8 * 33 * 8, NITEM_S = 128 * 8, NITEM = NITEM_P + NITEM_S;
constexpr float EPS = 1e-6f;

constexpr size_t O_YP = 0, O_YS = 16777216, O_PSC = 17825792, O_PGC = 17842176, O_PGS = 17915904, O_SSC = 18964480, O_SGC = 19226624, O_SGS = 20406272;

constexpr size_t U1 = (size_t)TP * 1024 * 2;
constexpr size_t W_GU1 = 0, W_D1 = W_GU1 + 11534336, W_QKV = W_D1 + 5767168, W_SC = W_QKV + 6815744, W_ZG = W_SC + 8388608,
                 W_WA = W_ZG + 4194304, W_WB = W_WA + 2097152, W_WO = W_WB + 2097152, W_GU2 = W_WO + 2097152, W_D2 = W_GU2 + 11534336, W_END = W_D2 + 5767168;
constexpr size_t OFF_XB = W_END, OFF_S0 = OFF_XB + U1, OFF_S1 = OFF_S0 + U1, OFF_S2 = OFF_S1 + U1, OFF_S3 = OFF_S2 + U1, OFF_SM = OFF_S3 + U1;
constexpr size_t OFF_RS0 = OFF_SM, OFF_P1 = OFF_RS0 + (size_t)TP * 4, OFF_P2 = OFF_P1 + (size_t)TP * 64, OFF_P3 = OFF_P2 + (size_t)TP * 64,
                 OFF_AB = OFF_P3 + (size_t)TP * 64, OFF_TAIL = OFF_AB + (size_t)TP * 64, OFF_HALO = OFF_TAIL + 256 * 1024 * 4,
                 OFF_GB = OFF_HALO + (size_t)8 * 33 * 3 * 3072 * 2, OFF_END = OFF_GB + (size_t)NITEM * 128 * 4;
constexpr size_t OFF_CTL = OFF_END, CTL_BYTES = 16384;
constexpr int CW_FIN = 3584;
constexpr size_t OFF_SSQ = OFF_CTL + CTL_BYTES;
constexpr size_t OFF_FINX = OFF_SSQ + (size_t)TP * 64 * 4;
static_assert(OFF_FINX + 64 * 4 * 256 * 4 <= 268435456, "ws map");
constexpr size_t TA_SAMPLE = (size_t)NITEM_P * 16384;
static_assert(TA_SAMPLE + (size_t)NITEM_S * 1024 <= U1, "TA fits slot 3");

struct Params {
    const float* in[25];
    float* out; unsigned char* ws;
    int ph_lo, ph_hi;
};

typedef float f32x2c_t __attribute__((ext_vector_type(2)));
typedef __bf16 bf16x2c_t __attribute__((ext_vector_type(2)));
__device__ __forceinline__ unsigned cvt_pk_bf16(float lo, float hi) { const f32x2c_t v = {lo, hi}; const bf16x2c_t b = __builtin_convertvector(v, bf16x2c_t); return __builtin_bit_cast(unsigned, b); }
__device__ __forceinline__ float bf_lo(unsigned w) { return __builtin_bit_cast(float, w << 16); }
__device__ __forceinline__ float bf_hi(unsigned w) { return __builtin_bit_cast(float, w & 0xffff0000u); }
__device__ __forceinline__ float bf1(bf16_t h) { return __builtin_bit_cast(float, ((unsigned)h) << 16); }
__device__ __forceinline__ bf16_t f2bf(float f) { return (bf16_t)(cvt_pk_bf16(f, 0.f) & 0xffffu); }
__device__ __forceinline__ float sigm(float x) { return __builtin_amdgcn_rcpf(1.f + __expf(-x)); }
__device__ __forceinline__ float siluf(float x) { return x * __builtin_amdgcn_rcpf(1.f + __expf(-x)); }
__device__ __forceinline__ float rs_from_part(const float* part, int row) {
    const f32x4* p = (const f32x4*)(part + (size_t)row * 16);
    const f32x4 a = p[0], b = p[1], c = p[2], d = p[3];
    const float s = (((a.x + a.y) + (a.z + a.w)) + ((b.x + b.y) + (b.z + b.w))) + (((c.x + c.y) + (c.z + c.w)) + ((d.x + d.y) + (d.z + d.w)));
    return rsqrtf(s * (1.f / 1024.f) + EPS);
}
__device__ __forceinline__ float rs_from_part4(const float* part, int row, int fq) {
    const f32x4 a = ((const f32x4*)(part + (size_t)row * 16))[fq];
    float s = (a.x + a.y) + (a.z + a.w);
    s += __shfl_xor(s, 16); s += __shfl_xor(s, 32);
    return rsqrtf(s * (1.f / 1024.f) + EPS);
}
__device__ __forceinline__ const float* xin_row(const Params& P, int row) {
    if (row < ROW_SAMPLE) return P.in[0] + (size_t)row * D;
    if (row < ROW_META) return P.in[1] + (size_t)(row - ROW_SAMPLE) * D;
    if (row < TREAL) return P.in[5] + (size_t)((row - ROW_META) & 15) * D;
    return nullptr;
}
__device__ __forceinline__ float* xres_row(const Params& P, int row) {
    if (row < ROW_META) return P.out + (size_t)row * D;
    return (float*)(P.ws + OFF_TAIL) + (size_t)(row - ROW_META) * D;
}

namespace pg8 {
constexpr int BM = 256, BK = 64, HALF = 128, HTB = HALF * BK * 2, STAGE_BYTES = 8 * HTB, NXCD = 8, WGM = 8;
__host__ __device__ __forceinline__ int lds_byte(int r, int c) { const int st = (r >> 4) * 2 + (c >> 5), rr = r & 15, cc = c & 31, ob = rr * 64 + cc * 2; return st * 1024 + (ob ^ (((ob >> 9) & 1) << 5)); }
__host__ __device__ __forceinline__ void stage_rc(int b, int& R, int& C) { const int st = b / 1024, sb = b % 1024, swz = sb ^ (((sb >> 9) & 1) << 5); R = (st >> 1) * 16 + swz / 64; C = (st & 1) * 32 + (swz % 64) / 2; }
__host__ __device__ __forceinline__ int perm32(int rho) { const int n = rho >> 4, i = rho & 15; return 8 * (i >> 2) + 4 * n + (i & 3); }

struct Unit { int pm, pn; };
struct Gemm { const bf16_t* A; const bf16_t* Bt; int M, N, K, lda, ldb; };

struct StaticOrder {
    int nM, nN, nwg, G, c;
    __host__ __device__ void init(int M, int N, int G_, int c_) { nM = M / BM; nN = N / BM; nwg = nM * nN; G = G_; c = c_; }
    __host__ __device__ bool next(int i, Unit& u) const {
        const long L = (long)i * G + c; if (L >= nwg) return false;
        int wgid = (int)L; { const int q = nwg / NXCD, r = nwg % NXCD, xcd = wgid % NXCD, off = wgid / NXCD; wgid = (xcd < r ? xcd * (q + 1) : r * (q + 1) + (xcd - r) * q) + off; }
        const int nig = WGM * nN, gid = wgid / nig, fm = gid * WGM, gsz = (nM - fm) < WGM ? (nM - fm) : WGM;
        u.pm = fm + ((wgid % nig) % gsz); u.pn = (wgid % nig) / gsz; return true;
    }
};

template <class Epi, bool FUSED = false>
__device__ __forceinline__ void gemm_phase(LAS unsigned char* lds, const Gemm g, const StaticOrder& S, const Epi& E) {
    const int tid = threadIdx.x, wid = __builtin_amdgcn_readfirstlane(tid >> 6), lane = tid & 63, wr = wid >> 2, wc = wid & 3, fr = lane & 15, fq = lane >> 4;
    const int K = g.K, nt = K / BK;
    unsigned voffA[2], voffB[2];
#pragma unroll
    for (int i = 0; i < 2; ++i) { int R, C; stage_rc(tid * 16 + i * 8192, R, C); const int Rb = (R & ~31) + perm32(R & 31);
        voffA[i] = (unsigned)(R * g.lda + C) * 2u; voffB[i] = (unsigned)(Rb * g.ldb + C) * 2u; }
    const size_t kstep = (size_t)(BK * 2);
    const size_t hstepA = (size_t)HALF * g.lda * 2, hstepB = (size_t)HALF * g.ldb * 2;
    const size_t tstepA = 2 * hstepA, tstepB = 2 * hstepB;
    const unsigned ldsw = (unsigned)wid * 1024u;
    const int aoff = lds_byte(wr * 64 + fr, fq * 8), boff = lds_byte(wc * 32 + fr, fq * 8);
#define PG8_SA(b, h) (((b) * 2 + (h)) * HTB)
#define PG8_SB(b, h) ((4 + (b) * 2 + (h)) * HTB)
#define PG8_STAGE(bufoff, gbase, voff) do { _Pragma("unroll") for (int _i = 0; _i < 2; ++_i) \
        __builtin_amdgcn_global_load_lds((const unsigned*)((const char*)(gbase) + (voff)[_i]), (LAS unsigned*)(lds + (bufoff) + ldsw + _i * 8192), 16, 0, 0); } while (0)
#define PG8_LDA(dst, b, h) do { _Pragma("unroll") for (int m = 0; m < 4; ++m) _Pragma("unroll") for (int k = 0; k < 2; ++k) dst[m][k] = *(const LAS bf16x8*)(lds + PG8_SA(b, h) + aoff + m * 2048 + k * 1024); } while (0)
#define PG8_LDB(dst, b, h) do { _Pragma("unroll") for (int n = 0; n < 2; ++n) _Pragma("unroll") for (int k = 0; k < 2; ++k) dst[n][k] = *(const LAS bf16x8*)(lds + PG8_SB(b, h) + boff + n * 2048 + k * 1024); } while (0)
#define PG8_MMA(ai, bj, At, Bt) do { __builtin_amdgcn_s_setprio(1); _Pragma("unroll") for (int m = 0; m < 4; ++m) _Pragma("unroll") for (int n = 0; n < 2; ++n) _Pragma("unroll") for (int k = 0; k < 2; ++k) \
        acc[ai][bj][m][n] = __builtin_amdgcn_mfma_f32_16x16x32_bf16(Bt[n][k], At[m][k], acc[ai][bj][m][n], 0, 0, 0); __builtin_amdgcn_s_setprio(0); } while (0)
#define PG8_WAIT_V(n) asm volatile("s_waitcnt vmcnt(" #n ")" ::: "memory")
#define PG8_WAIT_L(n) asm volatile("s_waitcnt lgkmcnt(" #n ")" ::: "memory")
#define PG8_BAR __builtin_amdgcn_s_barrier()
#define PG8_SCHED __builtin_amdgcn_sched_barrier(0)
    Unit cur, nxt; int ui = 0;
    if (!S.next(0, cur)) return;
    f32x4 acc[2][2][4][2];
#pragma unroll
    for (int a = 0; a < 2; ++a)
#pragma unroll
        for (int b = 0; b < 2; ++b)
#pragma unroll
            for (int m = 0; m < 4; ++m)
#pragma unroll
                for (int n = 0; n < 2; ++n) acc[a][b][m][n] = (f32x4){0.f, 0.f, 0.f, 0.f};
    bf16x8 At[4][2], B0[2][2], B1[2][2];
    const char* cA = (const char*)g.A + (size_t)cur.pm * tstepA; const char* cB = (const char*)g.Bt + (size_t)cur.pn * tstepB;
    PG8_STAGE(PG8_SB(0, 0), cB, voffB); PG8_STAGE(PG8_SB(0, 1), cB + hstepB, voffB); PG8_STAGE(PG8_SA(0, 0), cA, voffA); PG8_STAGE(PG8_SA(0, 1), cA + hstepA, voffA);
    if (wr == 1) PG8_BAR;
    PG8_WAIT_V(2); PG8_BAR;
    PG8_STAGE(PG8_SB(1, 0), cB + kstep, voffB); PG8_STAGE(PG8_SA(1, 0), cA + kstep, voffA); PG8_STAGE(PG8_SB(1, 1), cB + hstepB + kstep, voffB);
    PG8_WAIT_V(6); PG8_BAR;
    for (;;) {
        const bool has_next = S.next(ui + 1, nxt);
        const char* nA = has_next ? (const char*)g.A + (size_t)nxt.pm * tstepA : cA; const char* nB = has_next ? (const char*)g.Bt + (size_t)nxt.pn * tstepB : cB;
        for (int t = 0; t < nt; t += 2) {
            const bool last = (t == nt - 2);
            const char* a1 = cA + (size_t)(t + 1) * kstep;
            const char* a2 = last ? nA : cA + (size_t)(t + 2) * kstep; const char* b2 = last ? nB : cB + (size_t)(t + 2) * kstep;
            const char* a3 = a2 + kstep; const char* b3 = b2 + kstep;
            PG8_LDB(B0, 0, 0); PG8_LDB(B1, 0, 1); PG8_SCHED; PG8_LDA(At, 0, 0); PG8_STAGE(PG8_SA(1, 1), a1 + hstepA, voffA);
            PG8_WAIT_V(8); PG8_WAIT_L(0); PG8_BAR; PG8_MMA(0, 0, At, B0); PG8_MMA(0, 1, At, B1); PG8_BAR; PG8_SCHED;
            PG8_LDA(At, 0, 1); PG8_STAGE(PG8_SB(0, 0), b2, voffB); PG8_STAGE(PG8_SB(0, 1), b2 + hstepB, voffB); PG8_STAGE(PG8_SA(0, 0), a2, voffA);
            PG8_WAIT_V(8); PG8_WAIT_L(0); PG8_BAR; PG8_MMA(1, 0, At, B0); PG8_MMA(1, 1, At, B1); PG8_BAR; PG8_SCHED;
            PG8_LDB(B0, 1, 0); PG8_LDB(B1, 1, 1); PG8_SCHED; PG8_LDA(At, 1, 0); PG8_STAGE(PG8_SA(0, 1), a2 + hstepA, voffA);
            PG8_WAIT_V(8); PG8_WAIT_L(0); PG8_BAR; PG8_MMA(0, 0, At, B0); PG8_MMA(0, 1, At, B1); PG8_BAR; PG8_SCHED;
            PG8_LDA(At, 1, 1); PG8_STAGE(PG8_SB(1, 0), b3, voffB); PG8_STAGE(PG8_SB(1, 1), b3 + hstepB, voffB); PG8_STAGE(PG8_SA(1, 0), a3, voffA);
            PG8_WAIT_V(8); PG8_WAIT_L(0); PG8_BAR; PG8_MMA(1, 0, At, B0); PG8_MMA(1, 1, At, B1); PG8_BAR; PG8_SCHED;
        }
        if (wr == 0) PG8_BAR;
        if constexpr (!FUSED) E(acc, cur, wr, wc, fr, fq);
        if (!has_next) break;
#pragma unroll
        for (int a = 0; a < 2; ++a)
#pragma unroll
            for (int b = 0; b < 2; ++b)
#pragma unroll
                for (int m = 0; m < 4; ++m)
#pragma unroll
                    for (int n = 0; n < 2; ++n) acc[a][b][m][n] = (f32x4){0.f, 0.f, 0.f, 0.f};
        cur = nxt; cA = nA; cB = nB; ++ui;
        if (wr == 1) PG8_BAR;
    }
    PG8_WAIT_V(0);
    PG8_BAR;
    if constexpr (FUSED) E.fused(acc, cur, wr, wc, fr, fq, lds);
#undef PG8_SA
#undef PG8_SB
#undef PG8_STAGE
#undef PG8_LDA
#undef PG8_LDB
#undef PG8_MMA
#undef PG8_WAIT_V
#undef PG8_WAIT_L
#undef PG8_BAR
#undef PG8_SCHED
}
}
using pg8::Unit;
typedef f32x4 AccT[2][2][4][2];

struct EpiUp {
    const float* rs_single; const float* part; bf16_t* act;
    __device__ __forceinline__ void operator()(const AccT& acc, const Unit& u, int wr, int wc, int fr, int fq) const {
#pragma unroll
        for (int ai = 0; ai < 2; ++ai)
#pragma unroll
            for (int m = 0; m < 4; ++m) {
                const int row = u.pm * 256 + ai * 128 + wr * 64 + m * 16 + fr;
                const float rs = rs_single ? rs_single[row] : rs_from_part4(part, row, fq);
                const int f0 = u.pn * 128 + wc * 32 + fq * 8;
                const f32x4 g0 = acc[ai][0][m][0] * rs, g1 = acc[ai][0][m][1] * rs, u0 = acc[ai][1][m][0] * rs, u1 = acc[ai][1][m][1] * rs;
                u32x4 w; w.x = cvt_pk_bf16(siluf(g0[0]) * u0[0], siluf(g0[1]) * u0[1]); w.y = cvt_pk_bf16(siluf(g0[2]) * u0[2], siluf(g0[3]) * u0[3]);
                w.z = cvt_pk_bf16(siluf(g1[0]) * u1[0], siluf(g1[1]) * u1[1]); w.w = cvt_pk_bf16(siluf(g1[2]) * u1[2], siluf(g1[3]) * u1[3]);
                *(u32x4*)(act + (size_t)row * FF + f0) = w;
            }
    }
};
struct EpiRes {
    Params P; float scale; int first; bf16_t* xb; float* part;
    __device__ __forceinline__ void operator()(const AccT& acc, const Unit& u, int wr, int wc, int fr, int fq) const {
#pragma unroll
        for (int ai = 0; ai < 2; ++ai)
#pragma unroll
            for (int m = 0; m < 4; ++m) {
                const int row = u.pm * 256 + ai * 128 + wr * 64 + m * 16 + fr;
                float* xn = xres_row(P, row);
                const float* xo = first ? xin_row(P, row) : xn;
                float ss = 0.f;
#pragma unroll
                for (int bj = 0; bj < 2; ++bj) {
                    const int c0 = u.pn * 256 + bj * 128 + wc * 32 + fq * 8;
                    f32x4 o0 = (f32x4){0.f, 0.f, 0.f, 0.f}, o1 = o0;
                    if (xo) { o0 = *(const f32x4*)(xo + c0); o1 = *(const f32x4*)(xo + c0 + 4); }
                    const f32x4 v0 = o0 + acc[ai][bj][m][0] * scale, v1 = o1 + acc[ai][bj][m][1] * scale;
                    *(f32x4*)(xn + c0) = v0; *(f32x4*)(xn + c0 + 4) = v1;
                    ss += ((v0[0] * v0[0] + v0[1] * v0[1]) + (v0[2] * v0[2] + v0[3] * v0[3])) + ((v1[0] * v1[0] + v1[1] * v1[1]) + (v1[2] * v1[2] + v1[3] * v1[3]));
                    if (xb) { u32x4 w; w.x = cvt_pk_bf16(v0[0], v0[1]); w.y = cvt_pk_bf16(v0[2], v0[3]); w.z = cvt_pk_bf16(v1[0], v1[1]); w.w = cvt_pk_bf16(v1[2], v1[3]);
                        *(u32x4*)(xb + (size_t)row * D + c0) = w; }
                }
                ss += __shfl_xor(ss, 16); ss += __shfl_xor(ss, 32);
                if (fq == 0) part[(size_t)row * 16 + u.pn * 4 + wc] = ss;
            }
    }
    __device__ __forceinline__ float tail4(int row, int c0, f32x4 a) const {
        float* xn = xres_row(P, row);
        const float* xo = first ? xin_row(P, row) : xn;
        f32x4 o = (f32x4){0.f, 0.f, 0.f, 0.f};
        if (xo) o = *(const f32x4*)(xo + c0);
        const f32x4 v = o + a * scale;
        *(f32x4*)(xn + c0) = v;
        if (xb) { u32x2 w; w.x = cvt_pk_bf16(v[0], v[1]); w.y = cvt_pk_bf16(v[2], v[3]); *(u32x2*)(xb + (size_t)row * D + c0) = w; }
        return (v[0] * v[0] + v[1] * v[1]) + (v[2] * v[2] + v[3] * v[3]);
    }
    __device__ __forceinline__ void tail_row(int row, int cb, float ss, int fq) const { if (fq == 0) part[(size_t)row * 16 + cb] = ss; }
};
struct EpiQkv {
    Params P; const float* part;
    __device__ __forceinline__ void operator()(const AccT& acc, const Unit& u, int wr, int wc, int fr, int fq) const {
        unsigned char* ws = P.ws;
        if (u.pn < 12) {
            const int which = u.pn >> 2;
            bf16_t* buf = (bf16_t*)(ws + OFF_S0 + (size_t)which * U1);
#pragma unroll
            for (int ai = 0; ai < 2; ++ai)
#pragma unroll
                for (int m = 0; m < 4; ++m) {
                    const int row = u.pm * 256 + ai * 128 + wr * 64 + m * 16 + fr;
                    const float rs = rs_from_part4(part, row, fq);
                    bf16_t* halo = nullptr; float* fout = nullptr;
                    if (row < ROW_SAMPLE) { const int b = row >> 11, s = row & 2047, m64 = s & 63;
                        if (m64 >= 61) { const int c = (s >> 6) + 2, d = m64 - 61;
                            if (c <= 32) halo = (bf16_t*)(ws + OFF_HALO) + (size_t)((b * 33 + c) * 3 + d) * 3072;
                            else fout = P.out + O_PGC + (size_t)(b * 3 + d) * 3072; } }
                    else if (row < ROW_META) { const int i = (row - ROW_SAMPLE) >> 3, t = row & 7; if (t >= 5) fout = P.out + O_SGC + (size_t)(i * 3 + (t - 5)) * 3072; }
                    else if (row < TREAL) { const int b = (row - ROW_META) >> 4, mm = row & 15; if (mm >= 13) halo = (bf16_t*)(ws + OFF_HALO) + (size_t)((b * 33 + 1) * 3 + (mm - 13)) * 3072; }
#pragma unroll
                    for (int bj = 0; bj < 2; ++bj) {
                        const int c0 = (u.pn & 3) * 256 + bj * 128 + wc * 32 + fq * 8;
                        const f32x4 v0 = acc[ai][bj][m][0] * rs, v1 = acc[ai][bj][m][1] * rs;
                        u32x4 w; w.x = cvt_pk_bf16(v0[0], v0[1]); w.y = cvt_pk_bf16(v0[2], v0[3]); w.z = cvt_pk_bf16(v1[0], v1[1]); w.w = cvt_pk_bf16(v1[2], v1[3]);
                        *(u32x4*)(buf + (size_t)row * D + c0) = w;
                        if (halo) *(u32x4*)(halo + which * 1024 + c0) = w;
                        if (fout) { *(f32x4*)(fout + which * 1024 + c0) = v0; *(f32x4*)(fout + which * 1024 + c0 + 4) = v1; }
                    }
                }
        } else {
            float* ab = (float*)(ws + OFF_AB);
            if (wc == 0 && fq < 2) {
#pragma unroll
                for (int ai = 0; ai < 2; ++ai)
#pragma unroll
                    for (int m = 0; m < 4; ++m) {
                        const int row = u.pm * 256 + ai * 128 + wr * 64 + m * 16 + fr;
                        const float rs = rs_from_part(part, row);
                        *(f32x4*)(ab + (size_t)row * 16 + fq * 8) = acc[ai][0][m][0] * rs;
                        *(f32x4*)(ab + (size_t)row * 16 + fq * 8 + 4) = acc[ai][0][m][1] * rs;
                    }
            }
        }
    }
};
struct EpiSc {
    Params P; const float* part;
    __device__ __forceinline__ void operator()(const AccT& acc, const Unit& u, int wr, int wc, int fr, int fq) const {
        unsigned char* ws = P.ws;
        bf16_t* pbuf = (bf16_t*)(ws + OFF_S0); bf16_t* scb = (bf16_t*)(ws + OFF_S1); bf16_t* sga = (bf16_t*)(ws + OFF_S3);
        const bool isp = u.pn < 8; const int pn8 = u.pn & 7;
#pragma unroll
        for (int ai = 0; ai < 2; ++ai)
#pragma unroll
            for (int m = 0; m < 4; ++m) {
                const int row = u.pm * 256 + ai * 128 + wr * 64 + m * 16 + fr;
                const float rs = rs_from_part4(part, row, fq);
                const int ch0 = pn8 * 128 + wc * 32 + fq * 8;
                const f32x4 a0 = acc[ai][0][m][0] * rs, a1 = acc[ai][0][m][1] * rs, b0 = acc[ai][1][m][0] * rs, b1 = acc[ai][1][m][1] * rs;
                if (isp) {
                    float* fout = nullptr;
                    if (row < ROW_SAMPLE) { const int b = row >> 11, s = row & 2047; if (s >= 2046) fout = P.out + O_PSC + (size_t)(b * 2 + (s - 2046)) * 1024; }
                    else if (row < ROW_META) { const int i = (row - ROW_SAMPLE) >> 3, t = row & 7; if (t >= 6) fout = P.out + O_SSC + (size_t)(i * 2 + (t - 6)) * 1024; }
                    const f32x4 p0 = a0 * b0, p1 = a1 * b1;
                    u32x4 w; w.x = cvt_pk_bf16(p0[0], p0[1]); w.y = cvt_pk_bf16(p0[2], p0[3]); w.z = cvt_pk_bf16(p1[0], p1[1]); w.w = cvt_pk_bf16(p1[2], p1[3]);
                    *(u32x4*)(pbuf + (size_t)row * D + ch0) = w;
                    if (fout) { *(f32x4*)(fout + ch0) = p0; *(f32x4*)(fout + ch0 + 4) = p1; }
                } else {
                    u32x4 w; w.x = cvt_pk_bf16(a0[0], a0[1]); w.y = cvt_pk_bf16(a0[2], a0[3]); w.z = cvt_pk_bf16(a1[0], a1[1]); w.w = cvt_pk_bf16(a1[2], a1[3]);
                    *(u32x4*)(scb + (size_t)row * D + ch0) = w;
                    u32x4 g; g.x = cvt_pk_bf16(sigm(b0[0]), sigm(b0[1])); g.y = cvt_pk_bf16(sigm(b0[2]), sigm(b0[3])); g.z = cvt_pk_bf16(sigm(b1[0]), sigm(b1[1])); g.w = cvt_pk_bf16(sigm(b1[2]), sigm(b1[3]));
                    *(u32x4*)(sga + (size_t)row * D + ch0) = g;
                }
            }
    }
};
struct EpiZg {
    Params P; const float* part;
    __device__ __forceinline__ void operator()(const AccT& acc, const Unit& u, int wr, int wc, int fr, int fq) const {
        unsigned char* ws = P.ws;
        bf16_t* yb = (bf16_t*)(ws + OFF_S2); bf16_t* sgb = (bf16_t*)(ws + OFF_S0);
#pragma unroll
        for (int ai = 0; ai < 2; ++ai)
#pragma unroll
            for (int m = 0; m < 4; ++m) {
                const int row = u.pm * 256 + ai * 128 + wr * 64 + m * 16 + fr;
                const float rs = rs_from_part4(part, row, fq);
                const int cl = wc * 32 + fq * 8, ch0 = u.pn * 128 + cl;
                const f32x4 z0 = acc[ai][0][m][0] * rs, z1 = acc[ai][0][m][1] * rs, g0 = acc[ai][1][m][0] * rs, g1 = acc[ai][1][m][1] * rs;
                const u32x4 o = *(const u32x4*)(yb + (size_t)row * D + ch0);
                const f32x4* sp = (const f32x4*)((const float*)(ws + OFF_SSQ) + (size_t)row * 64 + u.pn * 8);
                const f32x4 q0 = sp[0], q1 = sp[1];
                const float rn = rsqrtf((((q0.x + q0.y) + (q0.z + q0.w)) + ((q1.x + q1.y) + (q1.z + q1.w))) * (1.f / 128.f) + EPS);
                const f32x4 n0 = *(const f32x4*)(P.in[16] + cl) * rn, n1 = *(const f32x4*)(P.in[16] + cl + 4) * rn;
                u32x4 w; w.x = cvt_pk_bf16(bf_lo(o.x) * n0.x * siluf(z0[0]), bf_hi(o.x) * n0.y * siluf(z0[1])); w.y = cvt_pk_bf16(bf_lo(o.y) * n0.z * siluf(z0[2]), bf_hi(o.y) * n0.w * siluf(z0[3]));
                w.z = cvt_pk_bf16(bf_lo(o.z) * n1.x * siluf(z1[0]), bf_hi(o.z) * n1.y * siluf(z1[1])); w.w = cvt_pk_bf16(bf_lo(o.w) * n1.z * siluf(z1[2]), bf_hi(o.w) * n1.w * siluf(z1[3]));
                *(u32x4*)(yb + (size_t)row * D + ch0) = w;
                u32x4 g; g.x = cvt_pk_bf16(sigm(g0[0]), sigm(g0[1])); g.y = cvt_pk_bf16(sigm(g0[2]), sigm(g0[3])); g.z = cvt_pk_bf16(sigm(g1[0]), sigm(g1[1])); g.w = cvt_pk_bf16(sigm(g1[2]), sigm(g1[3]));
                *(u32x4*)(sgb + (size_t)row * D + ch0) = g;
            }
    }
};
struct EpiGate {
    bf16_t* dst; const bf16_t* gate; int addprev;
    __device__ __forceinline__ void operator()(const AccT& acc, const Unit& u, int wr, int wc, int fr, int fq) const {
#pragma unroll
        for (int ai = 0; ai < 2; ++ai)
#pragma unroll
            for (int m = 0; m < 4; ++m) {
                const int row = u.pm * 256 + ai * 128 + wr * 64 + m * 16 + fr;
#pragma unroll
                for (int bj = 0; bj < 2; ++bj) {
                    const int c0 = u.pn * 256 + bj * 128 + wc * 32 + fq * 8;
                    const u32x4 gt = *(const u32x4*)(gate + (size_t)row * D + c0);
                    const f32x4 a0 = acc[ai][bj][m][0], a1 = acc[ai][bj][m][1];
                    float r[8] = {bf_lo(gt.x) * a0[0], bf_hi(gt.x) * a0[1], bf_lo(gt.y) * a0[2], bf_hi(gt.y) * a0[3], bf_lo(gt.z) * a1[0], bf_hi(gt.z) * a1[1], bf_lo(gt.w) * a1[2], bf_hi(gt.w) * a1[3]};
                    if (addprev) { const u32x4 pv = *(const u32x4*)(dst + (size_t)row * D + c0);
                        r[0] += bf_lo(pv.x); r[1] += bf_hi(pv.x); r[2] += bf_lo(pv.y); r[3] += bf_hi(pv.y); r[4] += bf_lo(pv.z); r[5] += bf_hi(pv.z); r[6] += bf_lo(pv.w); r[7] += bf_hi(pv.w); }
                    u32x4 w; w.x = cvt_pk_bf16(r[0], r[1]); w.y = cvt_pk_bf16(r[2], r[3]); w.z = cvt_pk_bf16(r[4], r[5]); w.w = cvt_pk_bf16(r[6], r[7]);
                    *(u32x4*)(dst + (size_t)row * D + c0) = w;
                }
            }
    }
    __device__ __forceinline__ float tail4(int row, int c0, f32x4 a) const {
        const u32x2 gt = *(const u32x2*)(gate + (size_t)row * D + c0);
        float r0 = bf_lo(gt.x) * a[0], r1 = bf_hi(gt.x) * a[1], r2 = bf_lo(gt.y) * a[2], r3 = bf_hi(gt.y) * a[3];
        if (addprev) { const u32x2 pv = *(const u32x2*)(dst + (size_t)row * D + c0); r0 += bf_lo(pv.x); r1 += bf_hi(pv.x); r2 += bf_lo(pv.y); r3 += bf_hi(pv.y); }
        u32x2 w; w.x = cvt_pk_bf16(r0, r1); w.y = cvt_pk_bf16(r2, r3);
        *(u32x2*)(dst + (size_t)row * D + c0) = w;
        return 0.f;
    }
    __device__ __forceinline__ void tail_row(int, int, float, int) const {}
};

struct EpiFinal {
    float* xio; const float* gfin; unsigned char* ws;
    __device__ __forceinline__ void operator()(const AccT&, const Unit&, int, int, int, int) const {}
    __device__ __forceinline__ void fused(AccT& acc, const Unit& u, int wr, int wc, int fr, int fq, LAS unsigned char* lds) const {
        LAS float* red = (LAS float*)lds;
        LAS float* rtab = (LAS float*)(lds + 4096);
        const int tid = threadIdx.x;
#pragma unroll
        for (int ai = 0; ai < 2; ++ai)
#pragma unroll
            for (int m = 0; m < 4; ++m) {
                const int rl = ai * 128 + wr * 64 + m * 16 + fr;
                const float* xr = xio + (size_t)(u.pm * 256 + rl) * D;
                float ss = 0.f;
#pragma unroll
                for (int bj = 0; bj < 2; ++bj) {
                    const int c0 = u.pn * 256 + bj * 128 + wc * 32 + fq * 8;
                    const f32x4 v0 = *(const f32x4*)(xr + c0) + acc[ai][bj][m][0] * 0.5f, v1 = *(const f32x4*)(xr + c0 + 4) + acc[ai][bj][m][1] * 0.5f;
                    acc[ai][bj][m][0] = v0; acc[ai][bj][m][1] = v1;
                    ss += ((v0[0] * v0[0] + v0[1] * v0[1]) + (v0[2] * v0[2] + v0[3] * v0[3])) + ((v1[0] * v1[0] + v1[1] * v1[1]) + (v1[2] * v1[2] + v1[3] * v1[3]));
                }
                ss += __shfl_xor(ss, 16); ss += __shfl_xor(ss, 32);
                if (fq == 0) red[rl * 4 + wc] = ss;
            }
        __syncthreads();
        unsigned* xch = (unsigned*)(ws + OFF_FINX) + (size_t)(u.pm * 4) * 256;
        if (tid < 256) { const f32x4 q = *(const LAS f32x4*)(red + tid * 4);
            __hip_atomic_store(xch + u.pn * 256 + tid, __builtin_bit_cast(unsigned, (q.x + q.y) + (q.z + q.w)), __ATOMIC_RELAXED, __HIP_MEMORY_SCOPE_AGENT); }
        asm volatile("s_waitcnt vmcnt(0)" ::: "memory");
        __syncthreads();
        if (tid == 0) {
            unsigned* cnt = (unsigned*)(ws + OFF_CTL) + CW_FIN + u.pm;
            __hip_atomic_fetch_add(cnt, 1u, __ATOMIC_RELAXED, __HIP_MEMORY_SCOPE_AGENT);
            unsigned sp = 0;
            while (__hip_atomic_load(cnt, __ATOMIC_RELAXED, __HIP_MEMORY_SCOPE_AGENT) < 4u) { __builtin_amdgcn_s_sleep(1); if (++sp > (1u << 22)) break; }
            __builtin_amdgcn_fence(__ATOMIC_ACQUIRE, "agent");
            asm volatile("s_waitcnt vmcnt(0)" ::: "memory");
        }
        __syncthreads();
        if (tid < 256) {
            float tot = 0.f;
#pragma unroll
            for (int j = 0; j < 4; ++j) tot += __builtin_bit_cast(float, __hip_atomic_load(xch + j * 256 + tid, __ATOMIC_RELAXED, __HIP_MEMORY_SCOPE_AGENT));
            rtab[tid] = rsqrtf(tot * (1.f / 1024.f) + EPS);
        }
        __syncthreads();
#pragma unroll
        for (int ai = 0; ai < 2; ++ai)
#pragma unroll
            for (int m = 0; m < 4; ++m) {
                const int rl = ai * 128 + wr * 64 + m * 16 + fr;
                const float r = rtab[rl];
                float* yr = xio + (size_t)(u.pm * 256 + rl) * D;
#pragma unroll
                for (int bj = 0; bj < 2; ++bj) {
                    const int c0 = u.pn * 256 + bj * 128 + wc * 32 + fq * 8;
                    *(f32x4*)(yr + c0) = acc[ai][bj][m][0] * r * *(const f32x4*)(gfin + c0);
                    *(f32x4*)(yr + c0 + 4) = acc[ai][bj][m][1] * r * *(const f32x4*)(gfin + c0 + 4);
                }
            }
    }
};

template <int MODE, int NCB = 16>
__device__ __forceinline__ void gemm_tail(const Params& P, LAS unsigned char* lds, const bf16_t* A, const int lda, const bf16_t* Bt, const int K,
                                          const float scale, const int first, bf16_t* xb, float* part, bf16_t* dst, const bf16_t* gate, const int addprev) {
    const int tid = threadIdx.x, wid = __builtin_amdgcn_readfirstlane(tid >> 6), lane = tid & 63, fr = lane & 15, fq = lane >> 4;
    constexpr int TP2 = 136;
    LAS bf16_t* Al = (LAS bf16_t*)lds;
    LAS bf16_t* Bl = (LAS bf16_t*)(lds + 2 * 80 * TP2 * 2);
    LAS float* ssum = (LAS float*)(lds + 2 * 80 * TP2 * 2 + 2 * 64 * TP2 * 2);
    const int nt = wid < 4 ? 3 : 2;
    const int nch = K / 128;
    constexpr int UPC = NCB / 16;
#pragma unroll 1
    for (int tu0 = blockIdx.x * UPC; tu0 < 16 * NCB; tu0 += gridDim.x * UPC)
#pragma unroll 1
    for (int tu = tu0; tu < tu0 + UPC; ++tu) {
        const int rb = tu / NCB, cb = tu % NCB;
        const int row0 = ROW_SAMPLE + rb * 80;
        const bf16_t* ga[3]; const bf16_t* gb[2];
#pragma unroll
        for (int j = 0; j < 3; ++j) { const int pz = tid + 512 * j; ga[j] = A + (size_t)(row0 + ((pz < 1280 ? pz : 0) >> 4)) * lda + (pz & 15) * 8; }
#pragma unroll
        for (int j = 0; j < 2; ++j) { const int pz = tid + 512 * j; gb[j] = Bt + (size_t)(cb * 64 + (pz >> 4)) * K + (pz & 15) * 8; }
        u32x4 ra[3], rbv[2];
#pragma unroll
        for (int j = 0; j < 3; ++j) ra[j] = *(const u32x4*)(ga[j]);
#pragma unroll
        for (int j = 0; j < 2; ++j) rbv[j] = *(const u32x4*)(gb[j]);
        f32x4 acc[3];
#pragma unroll
        for (int j = 0; j < 3; ++j) acc[j] = (f32x4){0.f, 0.f, 0.f, 0.f};
#pragma unroll 1
        for (int ch = 0; ch < nch; ++ch) {
            LAS bf16_t* Ab = Al + (ch & 1) * 80 * TP2; LAS bf16_t* Bb = Bl + (ch & 1) * 64 * TP2;
#pragma unroll
            for (int j = 0; j < 3; ++j) { const int pz = tid + 512 * j; if (pz < 1280) *(LAS u32x4*)(Ab + (pz >> 4) * TP2 + (pz & 15) * 8) = ra[j]; }
#pragma unroll
            for (int j = 0; j < 2; ++j) { const int pz = tid + 512 * j; *(LAS u32x4*)(Bb + (pz >> 4) * TP2 + (pz & 15) * 8) = rbv[j]; }
            if (ch + 1 < nch) {
#pragma unroll
                for (int j = 0; j < 3; ++j) ra[j] = *(const u32x4*)(ga[j] + (size_t)(ch + 1) * 128);
#pragma unroll
                for (int j = 0; j < 2; ++j) rbv[j] = *(const u32x4*)(gb[j] + (size_t)(ch + 1) * 128);
            }
            asm volatile("s_waitcnt lgkmcnt(0)" ::: "memory"); __builtin_amdgcn_s_barrier(); asm volatile("" ::: "memory");
#pragma unroll
            for (int ks = 0; ks < 4; ++ks) {
#pragma unroll
                for (int j = 0; j < 3; ++j) {
                    if (j < nt) { const int t = wid + 8 * j, rt = t >> 2, ct = t & 3;
                        const bf16x8 a = *(const LAS bf16x8*)(Bb + (16 * ct + fr) * TP2 + 32 * ks + 8 * fq);
                        const bf16x8 b = *(const LAS bf16x8*)(Ab + (16 * rt + fr) * TP2 + 32 * ks + 8 * fq);
                        acc[j] = __builtin_amdgcn_mfma_f32_16x16x32_bf16(a, b, acc[j], 0, 0, 0); }
                }
            }
        }
#pragma unroll
        for (int j = 0; j < 3; ++j) {
            if (j < nt) {
                const int t = wid + 8 * j, rt = t >> 2, ct = t & 3;
                const int row = row0 + 16 * rt + fr, c0 = cb * 64 + 16 * ct + 4 * fq;
                if (MODE == 0) {
                    float* xn = xres_row(P, row);
                    const float* xo = first ? xin_row(P, row) : xn;
                    f32x4 o = (f32x4){0.f, 0.f, 0.f, 0.f};
                    if (xo) o = *(const f32x4*)(xo + c0);
                    const f32x4 v = o + acc[j] * scale;
                    *(f32x4*)(xn + c0) = v;
                    if (xb) { u32x2 w; w.x = cvt_pk_bf16(v[0], v[1]); w.y = cvt_pk_bf16(v[2], v[3]); *(u32x2*)(xb + (size_t)row * D + c0) = w; }
                    float ss = (v[0] * v[0] + v[1] * v[1]) + (v[2] * v[2] + v[3] * v[3]);
                    ss += __shfl_xor(ss, 16); ss += __shfl_xor(ss, 32);
                    if (fq == 0) ssum[(16 * rt + fr) * 4 + ct] = ss;
                } else if (MODE == 2) {
                    const int ch0 = (cb >> 2) * 128 + (cb & 1) * 64 + 16 * ct + 4 * fq;
                    const float rs = rs_from_part4(part, row, fq);
                    const f32x4 val = acc[j] * rs;
                    if (((cb >> 1) & 1) == 0) {
                        const u32x2 o = *(const u32x2*)(dst + (size_t)row * D + ch0);
                        const f32x4* sp = (const f32x4*)((const float*)(P.ws + OFF_SSQ) + (size_t)row * 64 + (ch0 >> 7) * 8);
                        const f32x4 q0 = sp[0], q1 = sp[1];
                        const float rn = rsqrtf((((q0.x + q0.y) + (q0.z + q0.w)) + ((q1.x + q1.y) + (q1.z + q1.w))) * (1.f / 128.f) + EPS);
                        const f32x4 gn = *(const f32x4*)(P.in[16] + (ch0 & 127)) * rn;
                        u32x2 w; w.x = cvt_pk_bf16(bf_lo(o.x) * gn.x * siluf(val[0]), bf_hi(o.x) * gn.y * siluf(val[1])); w.y = cvt_pk_bf16(bf_lo(o.y) * gn.z * siluf(val[2]), bf_hi(o.y) * gn.w * siluf(val[3]));
                        *(u32x2*)(dst + (size_t)row * D + ch0) = w;
                    } else {
                        u32x2 g; g.x = cvt_pk_bf16(sigm(val[0]), sigm(val[1])); g.y = cvt_pk_bf16(sigm(val[2]), sigm(val[3]));
                        *(u32x2*)(xb + (size_t)row * D + ch0) = g;
                    }
                } else {
                    const u32x2 gt = *(const u32x2*)(gate + (size_t)row * D + c0);
                    float r0 = bf_lo(gt.x) * acc[j][0], r1 = bf_hi(gt.x) * acc[j][1], r2 = bf_lo(gt.y) * acc[j][2], r3 = bf_hi(gt.y) * acc[j][3];
                    if (addprev) { const u32x2 pv = *(const u32x2*)(dst + (size_t)row * D + c0); r0 += bf_lo(pv.x); r1 += bf_hi(pv.x); r2 += bf_lo(pv.y); r3 += bf_hi(pv.y); }
                    u32x2 w; w.x = cvt_pk_bf16(r0, r1); w.y = cvt_pk_bf16(r2, r3);
                    *(u32x2*)(dst + (size_t)row * D + c0) = w;
                }
            }
        }
        __syncthreads();
        if (MODE == 0 && tid < 80) part[(size_t)(row0 + tid) * 16 + cb] = (ssum[tid * 4] + ssum[tid * 4 + 1]) + (ssum[tid * 4 + 2] + ssum[tid * 4 + 3]);
        __syncthreads();
    }
}

__device__ __forceinline__ const float* wcol(const Params& P, int mat, int v, int& ld, const float*& gain) {
    gain = nullptr;
    if (mat == 0 || mat == 8) { const int n = (v >> 7) & 1, f = ((v >> 8) << 7) + (v & 127); ld = FF; gain = P.in[mat == 0 ? 6 : 20];
        return (mat == 0 ? (n ? P.in[8] : P.in[7]) : (n ? P.in[22] : P.in[21])) + f; }
    if (mat == 1) { ld = D; return P.in[9] + v; }
    if (mat == 9) { ld = D; return P.in[23] + v; }
    if (mat == 2) { ld = INC; gain = P.in[10]; if (v < 3072) return P.in[11] + 3072 + v; if (v < 3088) return P.in[11] + 6144 + (v - 3072); return nullptr; }
    if (mat == 3) { ld = INC; gain = P.in[10]; const int vv = v & 2047, n = (vv >> 7) & 1, ch = ((vv >> 8) << 7) + (vv & 127);
        const int col = (v < 2048) ? (n ? 2048 + ch : 1024 + ch) : (n ? 7184 + ch : ch); return P.in[11] + col; }
    if (mat == 4) { ld = INC; gain = P.in[10]; const int n = (v >> 7) & 1, ch = ((v >> 8) << 7) + (v & 127); return P.in[11] + (n ? 8208 + ch : 6160 + ch); }
    ld = D;
    if (mat == 5) return P.in[17] + v;
    if (mat == 6) return P.in[18] + v;
    return P.in[19] + v;
}
__device__ __forceinline__ void conv_item(const Params& P, int mat, int Nv, int K, bf16_t* WT, int item, LAS float* scr, int lane) {
    const int nblk = Nv / 32, kb = item / nblk, nb = item % nblk, k0 = 64 * kb, n0 = 32 * nb;
    int ld; const float* gain; const float* src = wcol(P, mat, n0 + (lane & 31), ld, gain);
    float vals[32];
#pragma unroll
    for (int i = 0; i < 32; ++i) { const int kk = 2 * i + (lane >> 5); vals[i] = src ? src[(size_t)(k0 + kk) * ld] : 0.f; }
    if (gain) {
#pragma unroll
        for (int i = 0; i < 32; ++i) { const int kk = 2 * i + (lane >> 5); vals[i] *= gain[k0 + kk]; }
    }
#pragma unroll
    for (int i = 0; i < 32; ++i) { const int kk = 2 * i + (lane >> 5); scr[kk * 33 + (lane & 31)] = vals[i]; }
    asm volatile("s_waitcnt lgkmcnt(0)" ::: "memory"); __builtin_amdgcn_wave_barrier();
    const int c = lane & 7;
#pragma unroll
    for (int j = 0; j < 4; ++j) { const int n = (lane >> 3) + 8 * j; const LAS float* s = scr + (8 * c) * 33 + n;
        u32x4 o; o.x = cvt_pk_bf16(s[0 * 33], s[1 * 33]); o.y = cvt_pk_bf16(s[2 * 33], s[3 * 33]); o.z = cvt_pk_bf16(s[4 * 33], s[5 * 33]); o.w = cvt_pk_bf16(s[6 * 33], s[7 * 33]);
        *(u32x4*)(WT + (size_t)(n0 + n) * K + k0 + 8 * c) = o; }
    asm volatile("s_waitcnt lgkmcnt(0)" ::: "memory"); __builtin_amdgcn_wave_barrier();
}
__device__ __forceinline__ float wave_sum(float v) {
#pragma unroll
    for (int o = 1; o < 64; o <<= 1) v += __shfl_xor(v, o);
    return v;
}
__device__ __forceinline__ void convert_weights(const Params& P, LAS unsigned char* lds, const int gw, const int NGW, const int mat_lo, const int mat_hi) {
    const int lane = threadIdx.x & 63, wave = threadIdx.x >> 6;
    LAS float* scr = (LAS float*)(lds + wave * 16384);
    unsigned char* ws = P.ws;
    constexpr int NV[10] = {5632, 1024, 3328, 4096, 2048, 1024, 1024, 1024, 5632, 1024};
    constexpr int KK[10] = {1024, 2816, 1024, 1024, 1024, 1024, 1024, 1024, 1024, 2816};
    const size_t WOFF[10] = {W_GU1, W_D1, W_QKV, W_SC, W_ZG, W_WA, W_WB, W_WO, W_GU2, W_D2};
    int base = 0;
#pragma unroll
    for (int mat = 0; mat < 10; ++mat) {
        if (mat < mat_lo || mat >= mat_hi) continue;
        const int nit = (KK[mat] / 64) * (NV[mat] / 32);
        const int first = (gw - (base % NGW) + NGW) % NGW;
        for (int it = first; it < nit; it += NGW) conv_item(P, mat, NV[mat], KK[mat], (bf16_t*)(ws + WOFF[mat]), it, scr, lane);
        base += nit;
    }
}
__device__ __forceinline__ void phase_prologue(const Params& P, LAS unsigned char* lds) {
    const int tid = threadIdx.x, lane = tid & 63, wave = tid >> 6;
    LAS float* scr = (LAS float*)(lds + wave * 16384);
    const int gw = blockIdx.x * 8 + wave, NGW = gridDim.x * 8;
    unsigned char* ws = P.ws;
    float* rs0 = (float*)(ws + OFF_RS0); bf16_t* xb = (bf16_t*)(ws + OFF_XB);
    for (int row0 = gw; row0 < TP; row0 += 2 * NGW) {
        const int row1 = row0 + NGW;
        const float* src0 = xin_row(P, row0); const float* src1 = row1 < TP ? xin_row(P, row1) : nullptr;
        f32x4 v0[4], v1[4];
#pragma unroll
        for (int j = 0; j < 4; ++j) { v0[j] = src0 ? ((const f32x4*)src0)[lane + 64 * j] : (f32x4){0.f, 0.f, 0.f, 0.f}; v1[j] = src1 ? ((const f32x4*)src1)[lane + 64 * j] : (f32x4){0.f, 0.f, 0.f, 0.f}; }
#pragma unroll
        for (int q = 0; q < 2; ++q) {
            const int row = q ? row1 : row0; const float* src = q ? src1 : src0;
            if (row >= TP) continue;
            float s = 0.f;
#pragma unroll
            for (int j = 0; j < 4; ++j) { const f32x4 v = q ? v1[j] : v0[j]; s += (v.x * v.x + v.y * v.y) + (v.z * v.z + v.w * v.w); }
            s = wave_sum(s);
            if (lane == 0) rs0[row] = src ? rsqrtf(s * (1.f / 1024.f) + EPS) : 0.f;
            u32x2* o8 = (u32x2*)(xb + (size_t)row * D) + lane;
#pragma unroll
            for (int j = 0; j < 4; ++j) { const f32x4 v = q ? v1[j] : v0[j]; u32x2 w; w.x = cvt_pk_bf16(v.x, v.y); w.y = cvt_pk_bf16(v.z, v.w); o8[64 * j] = w; }
        }
    }
    convert_weights(P, lds, gw, NGW, 0, gridDim.x >= 256 ? 3 : 10);
}

struct Item { int base_row, nreal, nv, h, kind  , seq, c; size_t ta_off; };
__device__ __forceinline__ Item item_decode(int item) {
    Item it;
    if (item < NITEM_P) { const int b = item / 264, c = (item >> 3) % 33; it.h = item & 7; it.seq = b; it.c = c;
        if (c == 0) { it.base_row = ROW_META + 16 * b; it.nreal = 16; it.kind = 1; } else { it.base_row = 2048 * b + 64 * (c - 1); it.nreal = 64; it.kind = 0; }
        it.nv = 64; it.ta_off = (size_t)item * 16384;
    } else { const int j = item - NITEM_P; it.seq = j >> 3; it.h = j & 7; it.c = 0; it.base_row = ROW_SAMPLE + 8 * it.seq; it.nreal = 8; it.kind = 2; it.nv = 16; it.ta_off = TA_SAMPLE + (size_t)j * 1024; }
    return it;
}
#define MFMA16(a, b, c) __builtin_amdgcn_mfma_f32_16x16x32_bf16((a), (b), (c), 0, 0, 0)
constexpr int KP = 136;
constexpr int TPI = 72;

typedef float f32x2 __attribute__((ext_vector_type(2)));
constexpr int PREP_WAVE_LDS = 17920;
__device__ __forceinline__ void lds_sync_wave() { asm volatile("s_waitcnt lgkmcnt(0)" ::: "memory"); __builtin_amdgcn_wave_barrier(); }
__device__ __forceinline__ void prep_stage_raw(const Params& P, const Item& it, const int wh, const int lane, LAS bf16_t* tile) {
    const int seg = lane & 7, c0 = it.h * 128 + seg * 16;
    const bf16_t* buf = (const bf16_t*)(P.ws + OFF_S0 + (size_t)wh * U1);
#pragma unroll 1
    for (int hb = 0; hb < 2; ++hb) {
        u32x4 a[4], b[4];
#pragma unroll
        for (int p = 0; p < 4; ++p) { const int r = 32 * hb + 8 * p + (lane >> 3);
            a[p] = (u32x4){0u, 0u, 0u, 0u}; b[p] = a[p];
            if (r < it.nreal) { const u32x4* q = (const u32x4*)(buf + (size_t)(it.base_row + r) * D + c0); a[p] = q[0]; b[p] = q[1]; } }
#pragma unroll
        for (int p = 0; p < 4; ++p) { const int r = 32 * hb + 8 * p + (lane >> 3); LAS u32x4* q = (LAS u32x4*)(tile + r * KP + seg * 16); q[0] = a[p]; q[1] = b[p]; }
    }
}
__device__ __forceinline__ void prep_pass(const Params& P, const Item& it, const int wh, const int p, const int lane, LAS bf16_t* tile, const bool dry, const f32x4 (&cw)[4][4]) {
    unsigned char* ws = P.ws;
    const int r = 8 * p + (lane >> 3), seg = lane & 7, c0 = it.h * 128 + seg * 16;
    bf16_t* buf = (bf16_t*)(ws + OFF_S0 + (size_t)wh * U1);
    float y[16];
#pragma unroll
    for (int e = 0; e < 16; ++e) y[e] = 0.f;
#pragma unroll
    for (int d = 0; d < 4; ++d) {
        const int rr = r - 3 + d;
        u32x4 a = (u32x4){0u, 0u, 0u, 0u}, b = a;
        if (r < it.nreal) {
            if (rr >= 0) { const LAS u32x4* q = (const LAS u32x4*)(tile + rr * KP + seg * 16); a = q[0]; b = q[1]; }
            else if (it.kind == 0) { const u32x4* q = (const u32x4*)((const bf16_t*)(ws + OFF_HALO) + (size_t)((it.seq * 33 + it.c) * 3 + (rr + 3)) * 3072 + wh * 1024 + c0); a = q[0]; b = q[1]; }
            else if (it.kind == 2) { const f32x4* q = (const f32x4*)(P.in[3] + (size_t)(it.seq * 3 + (rr + 3)) * 3072 + wh * 1024 + c0);
                { const f32x4 f0 = q[0], f1 = q[1]; a.x = cvt_pk_bf16(f0.x, f0.y); a.y = cvt_pk_bf16(f0.z, f0.w); a.z = cvt_pk_bf16(f1.x, f1.y); a.w = cvt_pk_bf16(f1.z, f1.w); }
                { const f32x4 f2 = q[2], f3 = q[3]; b.x = cvt_pk_bf16(f2.x, f2.y); b.y = cvt_pk_bf16(f2.z, f2.w); b.z = cvt_pk_bf16(f3.x, f3.y); b.w = cvt_pk_bf16(f3.z, f3.w); } }
        }
        { const f32x4 w0 = cw[d][0], w1 = cw[d][1];
          y[0] += w0.x * bf_lo(a.x); y[1] += w0.y * bf_hi(a.x); y[2] += w0.z * bf_lo(a.y); y[3] += w0.w * bf_hi(a.y);
          y[4] += w1.x * bf_lo(a.z); y[5] += w1.y * bf_hi(a.z); y[6] += w1.z * bf_lo(a.w); y[7] += w1.w * bf_hi(a.w); }
        { const f32x4 w2 = cw[d][2], w3 = cw[d][3];
          y[8] += w2.x * bf_lo(b.x); y[9] += w2.y * bf_hi(b.x); y[10] += w2.z * bf_lo(b.y); y[11] += w2.w * bf_hi(b.y);
          y[12] += w3.x * bf_lo(b.z); y[13] += w3.y * bf_hi(b.z); y[14] += w3.z * bf_lo(b.w); y[15] += w3.w * bf_hi(b.w); }
    }
    float ss = 0.f;
#pragma unroll
    for (int e = 0; e < 16; ++e) { y[e] = siluf(y[e]); ss += y[e] * y[e]; }
    float sc = 1.f;
    if (wh < 2) { ss += __shfl_xor(ss, 1); ss += __shfl_xor(ss, 2); ss += __shfl_xor(ss, 4);
        sc = rsqrtf(ss + 1e-6f) * (wh == 0 ? 0.08838834764831845f : 1.f); }
    u32x4 o0, o1;
    o0.x = cvt_pk_bf16(y[0] * sc, y[1] * sc); o0.y = cvt_pk_bf16(y[2] * sc, y[3] * sc); o0.z = cvt_pk_bf16(y[4] * sc, y[5] * sc); o0.w = cvt_pk_bf16(y[6] * sc, y[7] * sc);
    o1.x = cvt_pk_bf16(y[8] * sc, y[9] * sc); o1.y = cvt_pk_bf16(y[10] * sc, y[11] * sc); o1.z = cvt_pk_bf16(y[12] * sc, y[13] * sc); o1.w = cvt_pk_bf16(y[14] * sc, y[15] * sc);
    if (r >= it.nreal) { o0 = (u32x4){0u, 0u, 0u, 0u}; o1 = o0; }
    else if (!dry) { u32x4* q = (u32x4*)(buf + (size_t)(it.base_row + r) * D + c0); q[0] = o0; q[1] = o1; }
    asm volatile("s_waitcnt lgkmcnt(0)" ::: "memory");
    { LAS u32x4* q = (LAS u32x4*)(tile + r * KP + seg * 16); q[0] = o0; q[1] = o1; }
}
template <int NR>
__device__ __forceinline__ void prep_solve(const LAS float* Akk, bf16_t* tm, const int nv, const int lane, const bool dry) {
    f32x2 xa[NR / 2];
#pragma unroll
    for (int i = 0; i < NR / 2; ++i) xa[i] = (f32x2){0.f, 0.f};
#pragma unroll
    for (int i = 0; i < NR; ++i) {
        f32x2 s0 = (f32x2){0.f, 0.f}, s1 = s0;
#pragma unroll
        for (int j4 = 0; j4 < (i + 3) / 4; ++j4) {
            const f32x4 a = *(const LAS f32x4*)(Akk + i * 68 + 4 * j4);
            s0 += (f32x2){a.x, a.y} * xa[2 * j4]; s1 += (f32x2){a.z, a.w} * xa[2 * j4 + 1];
        }
        const float xi = ((lane == i) ? 1.f : 0.f) - ((s0.x + s0.y) + (s1.x + s1.y));
        if (i & 1) xa[i >> 1].y = xi; else xa[i >> 1].x = xi;
        if (lane < nv && !dry) tm[i * nv + lane] = f2bf(xi);
    }
}
__device__ __forceinline__ void prep_item(const Params& P, const int item, LAS unsigned char* wl, const int lane_in, const bool dry, const bool dryq) {
    int lane = lane_in; asm volatile("" : "+v"(lane));
    unsigned char* ws = P.ws;
    const Item it = item_decode(item);
    const int fr = lane & 15, fq = lane >> 4;
    LAS bf16_t* tile = (LAS bf16_t*)wl; LAS float* Akk = (LAS float*)wl; LAS float* gl = (LAS float*)(wl + 17408); LAS float* bl = gl + 64;
    const bool light = it.nreal < 64;
    const int npass = (it.nreal + 7) >> 3;
    bf16_t* tm = (bf16_t*)(ws + OFF_S3 + it.ta_off); bf16_t* aqk = tm + it.nv * it.nv;
    {
        float la = 0.f, be = 0.f;
        if (lane < it.nreal) { const float* ab = (const float*)(ws + OFF_AB) + (size_t)(it.base_row + lane) * 16;
            const float ar = ab[it.h] + P.in[15][it.h], br = ab[8 + it.h];
            const float sp = ar > 20.f ? ar : log1pf(expf(ar));
            la = -expf(P.in[14][it.h]) * sp; be = 1.f / (1.f + expf(-br)); }
#pragma unroll
        for (int o = 1; o < 64; o <<= 1) { const float t = __shfl_up(la, o); if (lane >= o) la += t; }
        gl[lane] = la; bl[lane] = be;
        if (!dry) { float* gb = (float*)(ws + OFF_GB) + (size_t)item * 128; gb[lane] = la; gb[64 + lane] = be; }
    }
    bf16x8 Qf[4][4];
#pragma unroll
    for (int t = 0; t < 4; ++t)
#pragma unroll
        for (int ks = 0; ks < 4; ++ks) Qf[t][ks] = (bf16x8){0, 0, 0, 0, 0, 0, 0, 0};
#pragma unroll 1
    for (int stage = 0; stage < 3; ++stage) {
        const int wh = stage == 0 ? 2 : stage - 1;
        lds_sync_wave();
        prep_stage_raw(P, it, wh, lane, tile);
        lds_sync_wave();
        f32x4 cw[4][4];
        { const float* convw = P.in[13] + wh * 1024 + it.h * 128 + (lane & 7) * 16;
#pragma unroll
          for (int d = 0; d < 4; ++d)
#pragma unroll
              for (int e = 0; e < 4; ++e) cw[d][e] = *(const f32x4*)(convw + (size_t)d * 3072 + 4 * e); }
#pragma unroll 1
        for (int p = npass - 1; p >= 0; --p) prep_pass(P, it, wh, p, lane, tile, dryq, cw);
        if (wh == 0) {
            lds_sync_wave();
#pragma unroll
            for (int t = 0; t < 4; ++t)
#pragma unroll
                for (int ks = 0; ks < 4; ++ks) Qf[t][ks] = *(const LAS bf16x8*)(tile + (16 * t + fr) * KP + 32 * ks + 8 * fq);
        }
    }
    lds_sync_wave();
#pragma unroll
    for (int mi = 0; mi < 4; ++mi) {
        const int i = 16 * mi + fr; const float gi = gl[i];
#pragma unroll
        for (int nj = 0; nj < 4; ++nj) {
            f32x4 d = (f32x4){0.f, 0.f, 0.f, 0.f};
            if (nj <= mi) {
#pragma unroll
                for (int ks = 0; ks < 4; ++ks) { const bf16x8 a = *(const LAS bf16x8*)(tile + (16 * nj + fr) * KP + 32 * ks + 8 * fq); d = MFMA16(a, Qf[mi][ks], d); }
            }
            const int j0 = 16 * nj + 4 * fq;
            f32x4 o;
#pragma unroll
            for (int rr = 0; rr < 4; ++rr) { const int j = j0 + rr; o[rr] = (nj <= mi && i >= j) ? d[rr] * __expf(gi - gl[j]) : 0.f; }
            if (i < it.nv && j0 < it.nv && !dry) { u32x2 w; w.x = cvt_pk_bf16(o[0], o[1]); w.y = cvt_pk_bf16(o[2], o[3]); *(u32x2*)(aqk + i * it.nv + j0) = w; }
        }
    }
    f32x4 kk[10];
#pragma unroll
    for (int mi = 0; mi < 4; ++mi) {
        bf16x8 Kb[4];
#pragma unroll
        for (int ks = 0; ks < 4; ++ks) Kb[ks] = *(const LAS bf16x8*)(tile + (16 * mi + fr) * KP + 32 * ks + 8 * fq);
#pragma unroll
        for (int nj = 0; nj <= mi; ++nj) {
            f32x4 d = (f32x4){0.f, 0.f, 0.f, 0.f};
#pragma unroll
            for (int ks = 0; ks < 4; ++ks) { const bf16x8 a = *(const LAS bf16x8*)(tile + (16 * nj + fr) * KP + 32 * ks + 8 * fq); d = MFMA16(a, Kb[ks], d); }
            kk[mi * (mi + 1) / 2 + nj] = d;
        }
    }
    lds_sync_wave();
#pragma unroll
    for (int mi = 0; mi < 4; ++mi) {
        const int i = 16 * mi + fr; const float gi = gl[i], bi = bl[i];
#pragma unroll
        for (int nj = 0; nj < 4; ++nj) {
            const int j0 = 16 * nj + 4 * fq;
            f32x4 o = (f32x4){0.f, 0.f, 0.f, 0.f};
            if (nj <= mi) {
                const f32x4 d = kk[mi * (mi + 1) / 2 + nj];
#pragma unroll
                for (int rr = 0; rr < 4; ++rr) { const int j = j0 + rr; o[rr] = (i > j) ? d[rr] * bi * __expf(gi - gl[j]) : 0.f; }
            }
            *(LAS f32x4*)(Akk + i * 68 + j0) = o;
        }
    }
    lds_sync_wave();
    if (!light) prep_solve<64>(Akk, tm, 64, lane, dry);
    else {
        prep_solve<16>(Akk, tm, it.nv, lane, dry);
        if (it.nv == 64 && !dry) for (int i = 16; i < 64; ++i) tm[i * 64 + lane] = (lane == i) ? (bf16_t)0x3F80u : (bf16_t)0u;
    }
    lds_sync_wave();
}
__device__ __forceinline__ void phase_prep(const Params& P, LAS unsigned char* lds, const bool dry = false, const bool dryq = false) {
    const int lane = threadIdx.x & 63, wave = __builtin_amdgcn_readfirstlane(threadIdx.x >> 6);
    LAS unsigned char* wl = lds + wave * PREP_WAVE_LDS;
    const int gw = blockIdx.x * 8 + wave, NGW = gridDim.x * 8;
#pragma unroll 1
    for (int sl = gw; sl < 2048 + 64 + NITEM_S; sl += NGW) {
        int item;
        if (sl < 2048) { const int b = sl >> 8, c = 1 + ((sl >> 3) & 31), h = sl & 7; item = (b * 33 + c) * 8 + h; }
        else { const int lt = sl - 2048; item = lt < 64 ? ((lt >> 3) * 33) * 8 + (lt & 7) : NITEM_P + (lt - 64); }
        prep_item(P, item, wl, lane, dry, dryq);
    }
}

__device__ __forceinline__ bf16x8 ldfrag_g(const bf16_t* base, int ld, int nvalid, int row, int col) {
    bf16x8 z = (bf16x8){0, 0, 0, 0, 0, 0, 0, 0};
    if (row < nvalid && col < ld) z = *(const bf16x8*)(base + (size_t)row * ld + col);
    return z;
}
#define REC_BAR() do { asm volatile("s_waitcnt lgkmcnt(0)" ::: "memory"); __builtin_amdgcn_s_barrier(); asm volatile("" ::: "memory"); } while (0)
template <int DVW>
__device__ __forceinline__ void rec_unit(const Params& P, LAS unsigned char* lds, const int item0, const int nchunks, const int h, const int dvs, const float* s0, float* sfin, const bool dry) {
    constexpr int TT = DVW / 32, ST = DVW / 16, HW = DVW / 2;
    const int tid = threadIdx.x, lane = tid & 63, wid = __builtin_amdgcn_readfirstlane(tid >> 6), fr = lane & 15, fq = lane >> 4;
    const int mi = wid & 3, nh = wid >> 2;
    unsigned char* ws = P.ws;
    LAS bf16_t* Sb = (LAS bf16_t*)lds;
    LAS bf16_t* Kl0 = (LAS bf16_t*)(lds + 34816);
    LAS bf16_t* Xt = (LAS bf16_t*)(lds + 52224);
    LAS bf16_t* NUt = (LAS bf16_t*)(lds + 70656);
    LAS bf16_t* NDt = (LAS bf16_t*)(lds + 89088);
    LAS float* gl0 = (LAS float*)(lds + 107520);
    const bf16_t* qbuf = (const bf16_t*)(ws + OFF_S0); const bf16_t* kbuf = (const bf16_t*)(ws + OFF_S1); bf16_t* vbuf = (bf16_t*)(ws + OFF_S2);
    float* ssqb = (float*)(ws + OFF_SSQ);
    const int i = 16 * mi + fr;
    f32x4 S[ST];
#pragma unroll
    for (int t = 0; t < ST; ++t) {
        if (s0) {
#pragma unroll
            for (int r = 0; r < 4; ++r) S[t][r] = s0[(size_t)(16 * wid + 4 * fq + r) * 128 + dvs + 16 * t + fr];
        } else S[t] = (f32x4){0.f, 0.f, 0.f, 0.f};
        u32x2 w; w.x = cvt_pk_bf16(S[t][0], S[t][1]); w.y = cvt_pk_bf16(S[t][2], S[t][3]);
        *(LAS u32x2*)(Sb + (16 * t + fr) * KP + 16 * wid + 4 * fq) = w;
    }
    bf16x8 pq[4], ptm[2], paq[2]; u32x2 pv[TT]; u32x4 pka, pkb; float pgb;
#define REC_PREFETCH(ITEM) do { const Item nx = item_decode(ITEM); \
        const bf16_t* tmn = (const bf16_t*)(ws + OFF_S3 + nx.ta_off); const bf16_t* aqn = tmn + nx.nv * nx.nv; \
        _Pragma("unroll") for (int ks = 0; ks < 4; ++ks) { pq[ks] = (bf16x8){0, 0, 0, 0, 0, 0, 0, 0}; \
            if (i < nx.nreal) pq[ks] = *(const bf16x8*)(qbuf + (size_t)(nx.base_row + i) * D + h * 128 + 32 * ks + 8 * fq); } \
        _Pragma("unroll") for (int t = 0; t < TT; ++t) { pv[t] = (u32x2){0u, 0u}; \
            if (i < nx.nreal) pv[t] = *(const u32x2*)(vbuf + (size_t)(nx.base_row + i) * D + h * 128 + dvs + HW * nh + 16 * t + 4 * fq); } \
        _Pragma("unroll") for (int ks = 0; ks < 2; ++ks) { ptm[ks] = ldfrag_g(tmn, nx.nv, nx.nv, i, 32 * ks + 8 * fq); paq[ks] = ldfrag_g(aqn, nx.nv, nx.nv, i, 32 * ks + 8 * fq); } \
        { const int r_ = tid >> 3, seg_ = tid & 7; pka = (u32x4){0u, 0u, 0u, 0u}; pkb = pka; \
          if (r_ < nx.nreal) { const u32x4* p_ = (const u32x4*)(kbuf + (size_t)(nx.base_row + r_) * D + h * 128 + seg_ * 16); pka = p_[0]; pkb = p_[1]; } } \
        pgb = (tid < 128) ? ((const float*)(ws + OFF_GB))[(size_t)(ITEM) * 128 + tid] : 0.f; } while (0)
    REC_PREFETCH(item0);
#pragma unroll 1
    for (int c = 0; c < nchunks; ++c) {
        const int item = item0 + c * 8;
        const Item it = item_decode(item);
        LAS bf16_t* Kl = (LAS bf16_t*)((LAS unsigned char*)Kl0 + (c & 1) * 73728);
        LAS float* gl = (LAS float*)((LAS unsigned char*)gl0 + (c & 1) * 18432); LAS float* bl = gl + 64;
        bf16x8 cq[4], ctm[2], caq[2]; u32x2 cv[TT];
#pragma unroll
        for (int ks = 0; ks < 4; ++ks) cq[ks] = pq[ks];
#pragma unroll
        for (int t = 0; t < TT; ++t) cv[t] = pv[t];
#pragma unroll
        for (int ks = 0; ks < 2; ++ks) { ctm[ks] = ptm[ks]; caq[ks] = paq[ks]; }
        { const int r = tid >> 3, seg = tid & 7; LAS u32x4* q = (LAS u32x4*)(Kl + r * KP + seg * 16); q[0] = pka; q[1] = pkb;
          if (tid < 128) gl[tid] = pgb; }
        __syncthreads();
        if (c + 1 < nchunks) REC_PREFETCH(item + 8);
        const float gi = gl[i], bi = bl[i], glast = gl[63];
        const float egi = __expf(gi), edi = __expf(glast - gi), egl = __expf(glast);
        f32x4 Pt[TT], Qt[TT];
#pragma unroll
        for (int t = 0; t < TT; ++t) { Pt[t] = (f32x4){0.f, 0.f, 0.f, 0.f}; Qt[t] = Pt[t]; }
#pragma unroll
        for (int ks = 0; ks < 4; ++ks) {
            const bf16x8 bk = *(const LAS bf16x8*)(Kl + i * KP + 32 * ks + 8 * fq);
#pragma unroll
            for (int t = 0; t < TT; ++t) {
                const bf16x8 a = *(const LAS bf16x8*)(Sb + (HW * nh + 16 * t + fr) * KP + 32 * ks + 8 * fq);
                Pt[t] = MFMA16(a, bk, Pt[t]); Qt[t] = MFMA16(a, cq[ks], Qt[t]);
            }
        }
#pragma unroll
        for (int t = 0; t < TT; ++t) {
            const int dv0 = HW * nh + 16 * t + 4 * fq;
            const u32x2 vv = cv[t];
            const float x0 = bi * (bf_lo(vv.x) - egi * Pt[t][0]), x1 = bi * (bf_hi(vv.x) - egi * Pt[t][1]), x2 = bi * (bf_lo(vv.y) - egi * Pt[t][2]), x3 = bi * (bf_hi(vv.y) - egi * Pt[t][3]);
            Xt[(dv0 + 0) * TPI + i] = f2bf(x0); Xt[(dv0 + 1) * TPI + i] = f2bf(x1); Xt[(dv0 + 2) * TPI + i] = f2bf(x2); Xt[(dv0 + 3) * TPI + i] = f2bf(x3);
        }
        REC_BAR();
        f32x4 Nu[TT];
#pragma unroll
        for (int t = 0; t < TT; ++t) Nu[t] = (f32x4){0.f, 0.f, 0.f, 0.f};
#pragma unroll
        for (int ks = 0; ks < 2; ++ks) {
#pragma unroll
            for (int t = 0; t < TT; ++t) {
                const bf16x8 a = *(const LAS bf16x8*)(Xt + (HW * nh + 16 * t + fr) * TPI + 32 * ks + 8 * fq);
                Nu[t] = MFMA16(a, ctm[ks], Nu[t]);
            }
        }
#pragma unroll
        for (int t = 0; t < TT; ++t) {
            const int dv0 = HW * nh + 16 * t + 4 * fq;
#pragma unroll
            for (int r = 0; r < 4; ++r) { NUt[(dv0 + r) * TPI + i] = f2bf(Nu[t][r]); NDt[(dv0 + r) * TPI + i] = f2bf(Nu[t][r] * edi); }
        }
        REC_BAR();
#pragma unroll
        for (int t = 0; t < TT; ++t) Qt[t] = Qt[t] * egi;
#pragma unroll
        for (int ks = 0; ks < 2; ++ks) {
#pragma unroll
            for (int t = 0; t < TT; ++t) {
                const bf16x8 a = *(const LAS bf16x8*)(NUt + (HW * nh + 16 * t + fr) * TPI + 32 * ks + 8 * fq);
                Qt[t] = MFMA16(a, caq[ks], Qt[t]);
            }
        }
#pragma unroll
        for (int t = 0; t < TT; ++t) {
            const int dvl = HW * nh + 16 * t;
            float sq = (Qt[t][0] * Qt[t][0] + Qt[t][1] * Qt[t][1]) + (Qt[t][2] * Qt[t][2] + Qt[t][3] * Qt[t][3]);
            sq += __shfl_xor(sq, 16); sq += __shfl_xor(sq, 32);
            if (i < it.nreal && !dry) {
                if (fq == 0) ssqb[(size_t)(it.base_row + i) * 64 + h * 8 + ((dvs + dvl) >> 4)] = sq;
                u32x2 w; w.x = cvt_pk_bf16(Qt[t][0], Qt[t][1]); w.y = cvt_pk_bf16(Qt[t][2], Qt[t][3]);
                *(u32x2*)(vbuf + (size_t)(it.base_row + i) * D + h * 128 + dvs + dvl + 4 * fq) = w;
            }
        }
#pragma unroll
        for (int t = 0; t < ST; ++t) S[t] = S[t] * egl;
#pragma unroll
        for (int ks = 0; ks < 2; ++ks) {
            bf16x8 a;
#pragma unroll
            for (int e = 0; e < 8; ++e) a[e] = (short)Kl[(32 * ks + 8 * fq + e) * KP + 16 * wid + fr];
#pragma unroll
            for (int t = 0; t < ST; ++t) {
                const bf16x8 b = *(const LAS bf16x8*)(NDt + (16 * t + fr) * TPI + 32 * ks + 8 * fq);
                S[t] = MFMA16(a, b, S[t]);
            }
        }
#pragma unroll
        for (int t = 0; t < ST; ++t) { u32x2 w; w.x = cvt_pk_bf16(S[t][0], S[t][1]); w.y = cvt_pk_bf16(S[t][2], S[t][3]);
            *(LAS u32x2*)(Sb + (16 * t + fr) * KP + 16 * wid + 4 * fq) = w; }
    }
#pragma unroll
    for (int t = 0; t < ST; ++t)
#pragma unroll
        for (int r = 0; r < 4; ++r) if (!dry) sfin[(size_t)(16 * wid + 4 * fq + r) * 128 + dvs + 16 * t + fr] = S[t][r];
    __syncthreads();
}
__device__ __forceinline__ void phase_rec(const Params& P, LAS unsigned char* lds, const bool dry = false) {
    const int G = gridDim.x, bx = blockIdx.x;
    if (G >= 256) {
        if (bx < 128) { const int chain = bx & 63, sl = bx >> 6, b = chain >> 3, h = chain & 7;
            rec_unit<64>(P, lds, b * 264 + h, 33, h, 64 * sl, nullptr, P.out + O_PGS + (size_t)chain * 16384, dry); }
        else {
#pragma unroll 1
            for (int j = bx - 128; j < 1024; j += G - 128)
                rec_unit<128>(P, lds, NITEM_P + j, 1, j & 7, 0, P.in[4] + (size_t)j * 16384, P.out + O_SGS + (size_t)j * 16384, dry);
            __syncthreads();
            convert_weights(P, lds, (bx - 128) * 8 + (int)(threadIdx.x >> 6), (G - 128) * 8, 3, 10);
        }
    } else {
#pragma unroll 1
        for (int pu = bx; pu < 128; pu += G) { const int chain = pu & 63, sl = pu >> 6, b = chain >> 3, h = chain & 7;
            rec_unit<64>(P, lds, b * 264 + h, 33, h, 64 * sl, nullptr, P.out + O_PGS + (size_t)chain * 16384, dry); }
#pragma unroll 1
        for (int j = bx; j < 1024; j += G)
            rec_unit<128>(P, lds, NITEM_P + j, 1, j & 7, 0, P.in[4] + (size_t)j * 16384, P.out + O_SGS + (size_t)j * 16384, dry);
    }
}

__device__ __forceinline__ void phase_ya(const Params& P) {
    unsigned char* ws = P.ws;
    const bf16_t* pbuf = (const bf16_t*)(ws + OFF_S0); bf16_t* scb = (bf16_t*)(ws + OFF_S1);
    const float* w = P.in[12];
    const long total = (long)TREAL * 128;
    for (long idx = (long)blockIdx.x * 512 + threadIdx.x; idx < total; idx += (long)gridDim.x * 512) {
        const int row = (int)(idx >> 7), c0 = (int)(idx & 127) * 8;
        int r1 = -1, r2 = -1; const float* f1 = nullptr; const float* f2 = nullptr;
        if (row < ROW_SAMPLE) { const int b = row >> 11, s = row & 2047;
            r1 = s >= 1 ? row - 1 : ROW_META + 16 * b + 15; r2 = s >= 2 ? row - 2 : ROW_META + 16 * b + 14 + s; }
        else if (row < ROW_META) { const int i = (row - ROW_SAMPLE) >> 3, t = row & 7;
            if (t >= 1) r1 = row - 1; else f1 = P.in[2] + (size_t)(i * 2 + 1) * 1024;
            if (t >= 2) r2 = row - 2; else f2 = P.in[2] + (size_t)(i * 2 + t) * 1024; }
        else { const int mm = row & 15; if (mm >= 1) r1 = row - 1; if (mm >= 2) r2 = row - 2; }
        float x0[8], x1[8], x2[8];
        { const u32x4 a = *(const u32x4*)(pbuf + (size_t)row * D + c0); x2[0] = bf_lo(a.x); x2[1] = bf_hi(a.x); x2[2] = bf_lo(a.y); x2[3] = bf_hi(a.y); x2[4] = bf_lo(a.z); x2[5] = bf_hi(a.z); x2[6] = bf_lo(a.w); x2[7] = bf_hi(a.w); }
        if (r1 >= 0) { const u32x4 a = *(const u32x4*)(pbuf + (size_t)r1 * D + c0); x1[0] = bf_lo(a.x); x1[1] = bf_hi(a.x); x1[2] = bf_lo(a.y); x1[3] = bf_hi(a.y); x1[4] = bf_lo(a.z); x1[5] = bf_hi(a.z); x1[6] = bf_lo(a.w); x1[7] = bf_hi(a.w); }
        else if (f1) { const f32x4 a = *(const f32x4*)(f1 + c0), b = *(const f32x4*)(f1 + c0 + 4); x1[0] = a.x; x1[1] = a.y; x1[2] = a.z; x1[3] = a.w; x1[4] = b.x; x1[5] = b.y; x1[6] = b.z; x1[7] = b.w; }
        else {
#pragma unroll
            for (int e = 0; e < 8; ++e) x1[e] = 0.f; }
        if (r2 >= 0) { const u32x4 a = *(const u32x4*)(pbuf + (size_t)r2 * D + c0); x0[0] = bf_lo(a.x); x0[1] = bf_hi(a.x); x0[2] = bf_lo(a.y); x0[3] = bf_hi(a.y); x0[4] = bf_lo(a.z); x0[5] = bf_hi(a.z); x0[6] = bf_lo(a.w); x0[7] = bf_hi(a.w); }
        else if (f2) { const f32x4 a = *(const f32x4*)(f2 + c0), b = *(const f32x4*)(f2 + c0 + 4); x0[0] = a.x; x0[1] = a.y; x0[2] = a.z; x0[3] = a.w; x0[4] = b.x; x0[5] = b.y; x0[6] = b.z; x0[7] = b.w; }
        else {
#pragma unroll
            for (int e = 0; e < 8; ++e) x0[e] = 0.f; }
        const u32x4 sb = *(const u32x4*)(scb + (size_t)row * D + c0);
        const float sbf[8] = {bf_lo(sb.x), bf_hi(sb.x), bf_lo(sb.y), bf_hi(sb.y), bf_lo(sb.z), bf_hi(sb.z), bf_lo(sb.w), bf_hi(sb.w)};
        float y[8];
#pragma unroll
        for (int e = 0; e < 8; ++e) y[e] = sbf[e] * (w[c0 + e] * x0[e] + w[1024 + c0 + e] * x1[e] + w[2048 + c0 + e] * x2[e]);
        u32x4 o; o.x = cvt_pk_bf16(y[0], y[1]); o.y = cvt_pk_bf16(y[2], y[3]); o.z = cvt_pk_bf16(y[4], y[5]); o.w = cvt_pk_bf16(y[6], y[7]);
        *(u32x4*)(scb + (size_t)row * D + c0) = o;
    }
}

__device__ __forceinline__ void phase_final(const Params& P, const int row_lo) {
    const int lane = threadIdx.x & 63, wave = threadIdx.x >> 6;
    const float* part = (const float*)(P.ws + OFF_P3); const float* gf = P.in[24];
    for (int row = row_lo + blockIdx.x * 8 + wave; row < ROW_META; row += gridDim.x * 8) {
        const float rs = rs_from_part(part, row);
        f32x4* x = (f32x4*)(P.out + (size_t)row * D);
#pragma unroll
        for (int j = 0; j < 4; ++j) { f32x4 v = x[lane + 64 * j]; const f32x4 g = ((const f32x4*)gf)[lane + 64 * j]; v = v * rs * g; x[lane + 64 * j] = v; }
    }
}


#define XB_TMO      128
#define XB_XCNT(j)  (256  + 64 * (j))
#define XB_XSUB(j)  (1280 + 64 * (j))
#define XB_XGEN(j)  (2304 + 64 * (j))
#define XB_TOP      3328
#define XB_TOPGEN   3392
#define XCD_BAR_WORDS 3456
#define XB_SPIN_CAP (1u << 22)
__device__ __forceinline__ unsigned xb_ld(unsigned* p)              { return __hip_atomic_load(p, __ATOMIC_RELAXED, __HIP_MEMORY_SCOPE_AGENT); }
__device__ __forceinline__ unsigned xb_add(unsigned* p, unsigned v) { return __hip_atomic_fetch_add(p, v, __ATOMIC_RELAXED, __HIP_MEMORY_SCOPE_AGENT); }
__device__ __forceinline__ unsigned xb_xcc_id() { return (unsigned)__builtin_amdgcn_s_getreg((3 << 11) | 20) & 0xFu; }
#define XB_SPIN(cond, bar) do { unsigned _sp = 0; while (cond) { __builtin_amdgcn_s_sleep(1); \
    if ((++_sp & 255u) == 0u) { if (xb_ld(&(bar)[XB_TMO])) break; if (_sp > XB_SPIN_CAP) { atomicAdd(&(bar)[XB_TMO], 1u); break; } } } } while (0)
struct XcdBarrier { unsigned* bar; unsigned x; volatile LAS unsigned* st; };
__device__ __forceinline__ XcdBarrier xcd_barrier_post(unsigned* bar, volatile LAS unsigned* st) {
    XcdBarrier b; b.bar = bar; b.x = xb_xcc_id(); b.st = st;
    if (threadIdx.x == 0) (void)xb_add(&bar[XB_XCNT(b.x)], 1u);
    return b;
}
__device__ __forceinline__ void xcd_barrier_complete(unsigned* bar, unsigned x, unsigned& nloc, unsigned& nx) {
    const unsigned G = gridDim.x * gridDim.y * gridDim.z;
    unsigned sum, cnt, mine, sp = 0u;
    for (;;) {
        sum = 0u; cnt = 0u; mine = 0u;
#pragma unroll
        for (unsigned j = 0; j < 16; ++j) { const unsigned c = xb_ld(&bar[XB_XCNT(j)]); sum += c; cnt += (c > 0u) ? 1u : 0u; mine = (j == x) ? c : mine; }
        if (sum == G) break;
        __builtin_amdgcn_s_sleep(1);
        if ((++sp & 255u) == 0u) { if (xb_ld(&bar[XB_TMO])) break; if (sp > XB_SPIN_CAP) { atomicAdd(&bar[XB_TMO], 1u); break; } }
    }
    nloc = mine > 0u ? mine : 1u; nx = cnt > 0u ? cnt : 1u;
}
__device__ __forceinline__ void xcd_barrier(const XcdBarrier& b) {
    asm volatile("s_waitcnt vmcnt(0)" ::: "memory");
    __syncthreads();
    if (threadIdx.x == 0) {
        unsigned* bar = b.bar;
        __builtin_amdgcn_s_waitcnt(0);
        unsigned nloc = b.st[0], nx = b.st[1];
        if (nloc == 0u) { xcd_barrier_complete(bar, b.x, nloc, nx); b.st[0] = nloc; b.st[1] = nx; }
        const unsigned old = xb_add(&bar[XB_XSUB(b.x)], 1u);
        const unsigned gen = old / nloc;
        if (old + 1u == (gen + 1u) * nloc) {
            __builtin_amdgcn_fence(__ATOMIC_RELEASE, "agent");
            asm volatile("s_waitcnt vmcnt(0)" ::: "memory");
            const unsigned og = xb_add(&bar[XB_TOP], 1u);
            const unsigned tg = og / nx;
            if (og + 1u == (tg + 1u) * nx) xb_add(&bar[XB_TOPGEN], 1u);
            else XB_SPIN(xb_ld(&bar[XB_TOPGEN]) == tg, bar);
            __builtin_amdgcn_fence(__ATOMIC_ACQUIRE, "agent");
            xb_add(&bar[XB_XGEN(b.x)], 1u);
            asm volatile("s_waitcnt vmcnt(0)" ::: "memory");
        } else {
            XB_SPIN(xb_ld(&bar[XB_XGEN(b.x)]) == gen, bar);
            __builtin_amdgcn_fence(__ATOMIC_ACQUIRE, "agent");
            asm volatile("s_waitcnt vmcnt(0)" ::: "memory");
        }
    }
    __syncthreads();
}

constexpr int NPHASE = 15;
constexpr int LDS_BYTES = 147456;
__global__ void __launch_bounds__(512, 2) mega(Params P) {
    extern __shared__ __attribute__((aligned(16))) unsigned char lds_raw[];
    LAS unsigned char* lds = (LAS unsigned char*)lds_raw;
    unsigned char* ws = P.ws;
    const int G = gridDim.x, cid = blockIdx.x;
    volatile LAS unsigned* bst = (volatile LAS unsigned*)(lds + 147392);
    XcdBarrier xbar; xbar.bar = (unsigned*)(ws + OFF_CTL); xbar.x = 0; xbar.st = bst;
    if (P.ph_hi - P.ph_lo > 1) {
        if (threadIdx.x < 2) bst[threadIdx.x] = 0u;
        __syncthreads();
        xbar = xcd_barrier_post((unsigned*)(ws + OFF_CTL), bst);
        cg::this_grid().sync();
    }
    bf16_t* xb = (bf16_t*)(ws + OFF_XB);
    bf16_t* S0 = (bf16_t*)(ws + OFF_S0); bf16_t* S1 = (bf16_t*)(ws + OFF_S1); bf16_t* S2 = (bf16_t*)(ws + OFF_S2); bf16_t* S3 = (bf16_t*)(ws + OFF_S3);
    float* P1 = (float*)(ws + OFF_P1); float* P2 = (float*)(ws + OFF_P2); float* P3 = (float*)(ws + OFF_P3);
#define IN(k) (P.ph_lo <= (k) && (k) < P.ph_hi)
#define SEAM(k) do { if (IN(k) && IN((k) + 1)) { xcd_barrier(xbar); } } while (0)
#define GEMM1K(EpiT, E, Aptr, lda_, Bptr, K_) do { pg8::Gemm g{(const bf16_t*)(Aptr), (const bf16_t*)(Bptr), ROW_SAMPLE, D, (K_), (lda_), (K_)}; \
        pg8::StaticOrder S; S.init(ROW_SAMPLE, D, G, cid); pg8::gemm_phase<EpiT>(lds, g, S, E); } while (0)
#define GEMM(EpiT, E, Aptr, lda_, Bptr, N_, K_) do { pg8::Gemm g{(const bf16_t*)(Aptr), (const bf16_t*)(Bptr), TP, (N_), (K_), (lda_), (K_)}; \
        pg8::StaticOrder S; S.init(TP, (N_), G, cid); pg8::gemm_phase<EpiT>(lds, g, S, E); } while (0)

    if ((PROBE & 16) && IN(0)) { phase_prologue(P, lds); xcd_barrier(xbar); }
    if (IN(0)) { phase_prologue(P, lds); } SEAM(0);
    if (IN(1)) { EpiUp E{(const float*)(ws + OFF_RS0), nullptr, S0}; GEMM(EpiUp, E, xb, D, ws + W_GU1, 2 * FF, D); } SEAM(1);
    if ((PROBE & 4) && IN(1)) { EpiUp E{(const float*)(ws + OFF_RS0), nullptr, S0}; GEMM(EpiUp, E, xb, D, ws + W_GU1, 2 * FF, D); xcd_barrier(xbar); }
    if ((PROBE & 8) && IN(2)) { EpiRes E{P, 0.5f, 1, xb, P1}; GEMM(EpiRes, E, S0, FF, ws + W_D1, D, FF); xcd_barrier(xbar); }
    if (IN(2)) { EpiRes E{P, 0.5f, 1, xb, P1}; GEMM1K(EpiRes, E, S0, FF, ws + W_D1, FF); gemm_tail<0>(P, lds, S0, FF, (const bf16_t*)(ws + W_D1), FF, 0.5f, 1, xb, P1, nullptr, nullptr, 0); } SEAM(2);
    if (IN(3)) { EpiQkv E{P, P1}; GEMM(EpiQkv, E, xb, D, ws + W_QKV, 3328, D); } SEAM(3);
    const bool dryrt = (P.ph_hi < 1000);
    if ((PROBE & 1) && IN(4)) { phase_prep(P, lds, dryrt); xcd_barrier(xbar); }
    if (IN(4)) { phase_prep(P, lds); } SEAM(4);
    if ((PROBE & 2) && IN(5)) { phase_rec(P, lds, dryrt); xcd_barrier(xbar); }
    if (IN(5)) { phase_rec(P, lds); } SEAM(5);
    if (IN(6)) { EpiSc E{P, P1}; GEMM(EpiSc, E, xb, D, ws + W_SC, 4096, D); } SEAM(6);
    if (IN(7)) { phase_ya(P); } SEAM(7);
    if (IN(8)) { EpiGate E{S3, S3, 0}; GEMM1K(EpiGate, E, S1, D, ws + W_WA, D); gemm_tail<1>(P, lds, S1, D, (const bf16_t*)(ws + W_WA), D, 0.f, 0, nullptr, nullptr, S3, S3, 0); } if (!IN(9)) { SEAM(8); }
    if (IN(9)) { EpiZg E{P, P1}; { pg8::Gemm g{(const bf16_t*)xb, (const bf16_t*)(ws + W_ZG), ROW_SAMPLE, 2048, D, D, D}; pg8::StaticOrder S; S.init(ROW_SAMPLE, 2048, G, cid); pg8::gemm_phase<EpiZg>(lds, g, S, E); }
        gemm_tail<2, 32>(P, lds, xb, D, (const bf16_t*)(ws + W_ZG), D, 0.f, 0, S0, P1, S2, nullptr, 0); } SEAM(9);
    if (IN(10)) { EpiGate E{S3, S0, 1}; GEMM1K(EpiGate, E, S2, D, ws + W_WB, D); gemm_tail<1>(P, lds, S2, D, (const bf16_t*)(ws + W_WB), D, 0.f, 0, nullptr, nullptr, S3, S0, 1); } SEAM(10);
    if (IN(11)) { EpiRes E{P, 1.0f, 0, xb, P2}; GEMM1K(EpiRes, E, S3, D, ws + W_WO, D); gemm_tail<0>(P, lds, S3, D, (const bf16_t*)(ws + W_WO), D, 1.0f, 0, xb, P2, nullptr, nullptr, 0); } SEAM(11);
    if (IN(12)) { EpiUp E{nullptr, P2, S0}; GEMM(EpiUp, E, xb, D, ws + W_GU2, 2 * FF, D); } SEAM(12);
    if (IN(13)) { EpiFinal EF{P.out, P.in[24], ws};
        { pg8::Gemm g{(const bf16_t*)S0, (const bf16_t*)(ws + W_D2), ROW_SAMPLE, D, FF, FF, FF}; pg8::StaticOrder S; S.init(ROW_SAMPLE, D, G, cid);
          if (G == 256) pg8::gemm_phase<EpiFinal, true>(lds, g, S, EF);
          else { EpiRes E{P, 0.5f, 0, nullptr, P3}; pg8::gemm_phase<EpiRes>(lds, g, S, E); } }
        gemm_tail<0>(P, lds, S0, FF, (const bf16_t*)(ws + W_D2), FF, 0.5f, 0, nullptr, P3, nullptr, nullptr, 0); } SEAM(13);
    if (IN(14)) { phase_final(P, G == 256 ? ROW_SAMPLE : 0); }
#undef IN
#undef SEAM
#undef GEMM
#undef GEMM1K
}

extern "C" void kernel_launch(void* const* d_in, const int* in_sizes, int n_in, void* d_out, int out_size, void* d_ws, size_t ws_size, hipStream_t stream) {
    static int grid = 0;
    if (grid == 0) {
        if (n_in != 25 || ws_size < OFF_FINX + 64 * 4 * 256 * 4) { fprintf(stderr, "kernel_launch: unexpected problem (n_in %d, ws %zu)\n", n_in, ws_size); grid = -1; return; }
        int dev = 0, cus = 0, per_cu = 0;
        hipGetDevice(&dev); hipDeviceGetAttribute(&cus, hipDeviceAttributeMultiprocessorCount, dev);
        if (hipFuncSetAttribute((const void*)mega, hipFuncAttributeMaxDynamicSharedMemorySize, LDS_BYTES) != hipSuccess) { fprintf(stderr, "kernel_launch: hipFuncSetAttribute failed\n"); grid = -1; return; }
        if (hipOccupancyMaxActiveBlocksPerMultiprocessor(&per_cu, (const void*)mega, 512, LDS_BYTES) != hipSuccess || per_cu < 1) { fprintf(stderr, "kernel_launch: occupancy query failed (%d)\n", per_cu); (void)hipGetLastError(); per_cu = 1; }
        grid = cus * per_cu;
    }
    if (grid < 0) return;
    Params p{};
    for (int i = 0; i < 25; ++i) p.in[i] = (const float*)d_in[i];
    p.out = (float*)d_out; p.ws = (unsigned char*)d_ws;
#if ONE_LAUNCH
    if (hipMemsetAsync((char*)d_ws + OFF_CTL, 0, CTL_BYTES, stream) != hipSuccess) { fprintf(stderr, "memset failed\n"); return; }
    p.ph_lo = 0; p.ph_hi = NPHASE;
    void* args[] = {&p};
    hipError_t e = hipLaunchCooperativeKernel((const void*)mega, dim3(grid), dim3(512), args, LDS_BYTES, stream);
    if (e != hipSuccess) fprintf(stderr, "cooperative launch failed: %s (grid %d)\n", hipGetErrorString(e), grid);
#else
    for (int k = 0; k < NPHASE; ++k) {
        p.ph_lo = k; p.ph_hi = k + 1;
        hipLaunchKernelGGL(mega, dim3(grid), dim3(512), LDS_BYTES, stream, p);
    }
#endif
}
```

```cpp
#include <hip/hip_runtime.h>
#include <hip/hip_cooperative_groups.h>
#include <cstdio>
#include <cstdint>
namespace cg = cooperative_groups;

#ifndef PROBE
#define PROBE 0
#endif
#ifndef ONE_LAUNCH
#define ONE_LAUNCH 1
#endif

#define LAS __attribute__((address_space(3)))
typedef unsigned short bf16_t;
typedef short bf16x8 __attribute__((ext_vector_type(8)));
typedef float f32x4 __attribute__((ext_vector_type(4)));
typedef unsigned u32x4 __attribute__((ext_vector_type(4)));
typedef unsigned u32x2 __attribute__((ext_vector_type(2)));

constexpr int TP = 17664, TREAL = 17536, ROW_SAMPLE = 16384, ROW_META = 17408;
constexpr int D = 1024, FF = 2816, INC = 9232;
constexpr int NITEM_P = 8 * 33 * 8, NITEM_S = 128 * 8, NITEM = NITEM_P + NITEM_S;
constexpr float EPS = 1e-6f;

constexpr size_t O_YP = 0, O_YS = 16777216, O_PSC = 17825792, O_PGC = 17842176, O_PGS = 17915904, O_SSC = 18964480, O_SGC = 19226624, O_SGS = 20406272;

constexpr size_t U1 = (size_t)TP * 1024 * 2;
constexpr size_t W_GU1 = 0, W_D1 = W_GU1 + 11534336, W_QKV = W_D1 + 5767168, W_SC = W_QKV + 6815744, W_ZG = W_SC + 8388608,
                 W_WA = W_ZG + 4194304, W_WB = W_WA + 2097152, W_WO = W_WB + 2097152, W_GU2 = W_WO + 2097152, W_D2 = W_GU2 + 11534336, W_END = W_D2 + 5767168;
constexpr size_t OFF_XB = W_END, OFF_S0 = OFF_XB + U1, OFF_S1 = OFF_S0 + U1, OFF_S2 = OFF_S1 + U1, OFF_S3 = OFF_S2 + U1, OFF_SM = OFF_S3 + U1;
constexpr size_t OFF_RS0 = OFF_SM, OFF_P1 = OFF_RS0 + (size_t)TP * 4, OFF_P2 = OFF_P1 + (size_t)TP * 64, OFF_P3 = OFF_P2 + (size_t)TP * 64,
                 OFF_AB = OFF_P3 + (size_t)TP * 64, OFF_TAIL = OFF_AB + (size_t)TP * 64, OFF_HALO = OFF_TAIL + 256 * 1024 * 4,
                 OFF_GB = OFF_HALO + (size_t)8 * 33 * 3 * 3072 * 2, OFF_END = OFF_GB + (size_t)NITEM * 128 * 4;
constexpr size_t OFF_CTL = OFF_END, CTL_BYTES = 16384;
constexpr int CW_FIN = 3584;
constexpr size_t OFF_SSQ = OFF_CTL + CTL_BYTES;
constexpr size_t OFF_FINX = OFF_SSQ + (size_t)TP * 64 * 4;
static_assert(OFF_FINX + 64 * 4 * 256 * 4 <= 268435456, "ws map");
constexpr size_t TA_SAMPLE = (size_t)NITEM_P * 16384;
static_assert(TA_SAMPLE + (size_t)NITEM_S * 1024 <= U1, "TA fits slot 3");

struct Params {
    const float* in[25];
    float* out; unsigned char* ws;
    int ph_lo, ph_hi;
};

typedef float f32x2c_t __attribute__((ext_vector_type(2)));
typedef __bf16 bf16x2c_t __attribute__((ext_vector_type(2)));
__device__ __forceinline__ unsigned cvt_pk_bf16(float lo, float hi) { const f32x2c_t v = {lo, hi}; const bf16x2c_t b = __builtin_convertvector(v, bf16x2c_t); return __builtin_bit_cast(unsigned, b); }
__device__ __forceinline__ float bf_lo(unsigned w) { return __builtin_bit_cast(float, w << 16); }
__device__ __forceinline__ float bf_hi(unsigned w) { return __builtin_bit_cast(float, w & 0xffff0000u); }
__device__ __forceinline__ float bf1(bf16_t h) { return __builtin_bit_cast(float, ((unsigned)h) << 16); }
__device__ __forceinline__ bf16_t f2bf(float f) { return (bf16_t)(cvt_pk_bf16(f, 0.f) & 0xffffu); }
__device__ __forceinline__ float sigm(float x) { return __builtin_amdgcn_rcpf(1.f + __expf(-x)); }
__device__ __forceinline__ float siluf(float x) { return x * __builtin_amdgcn_rcpf(1.f + __expf(-x)); }
__device__ __forceinline__ float rs_from_part(const float* part, int row) {
    const f32x4* p = (const f32x4*)(part + (size_t)row * 16);
    const f32x4 a = p[0], b = p[1], c = p[2], d = p[3];
    const float s = (((a.x + a.y) + (a.z + a.w)) + ((b.x + b.y) + (b.z + b.w))) + (((c.x + c.y) + (c.z + c.w)) + ((d.x + d.y) + (d.z + d.w)));
    return rsqrtf(s * (1.f / 1024.f) + EPS);
}
__device__ __forceinline__ float rs_from_part4(const float* part, int row, int fq) {
    const f32x4 a = ((const f32x4*)(part + (size_t)row * 16))[fq];
    float s = (a.x + a.y) + (a.z + a.w);
    s += __shfl_xor(s, 16); s += __shfl_xor(s, 32);
    return rsqrtf(s * (1.f / 1024.f) + EPS);
}
__device__ __forceinline__ const float* xin_row(const Params& P, int row) {
    if (row < ROW_SAMPLE) return P.in[0] + (size_t)row * D;
    if (row < ROW_META) return P.in[1] + (size_t)(row - ROW_SAMPLE) * D;
    if (row < TREAL) return P.in[5] + (size_t)((row - ROW_META) & 15) * D;
    return nullptr;
}
__device__ __forceinline__ float* xres_row(const Params& P, int row) {
    if (row < ROW_META) return P.out + (size_t)row * D;
    return (float*)(P.ws + OFF_TAIL) + (size_t)(row - ROW_META) * D;
}

namespace pg8 {
constexpr int BM = 256, BK = 64, HALF = 128, HTB = HALF * BK * 2, STAGE_BYTES = 8 * HTB, NXCD = 8, WGM = 8;
__host__ __device__ __forceinline__ int lds_byte(int r, int c) { const int st = (r >> 4) * 2 + (c >> 5), rr = r & 15, cc = c & 31, ob = rr * 64 + cc * 2; return st * 1024 + (ob ^ (((ob >> 9) & 1) << 5)); }
__host__ __device__ __forceinline__ void stage_rc(int b, int& R, int& C) { const int st = b / 1024, sb = b % 1024, swz = sb ^ (((sb >> 9) & 1) << 5); R = (st >> 1) * 16 + swz / 64; C = (st & 1) * 32 + (swz % 64) / 2; }
__host__ __device__ __forceinline__ int perm32(int rho) { const int n = rho >> 4, i = rho & 15; return 8 * (i >> 2) + 4 * n + (i & 3); }

struct Unit { int pm, pn; };
struct Gemm { const bf16_t* A; const bf16_t* Bt; int M, N, K, lda, ldb; };

struct StaticOrder {
    int nM, nN, nwg, G, c;
    __host__ __device__ void init(int M, int N, int G_, int c_) { nM = M / BM; nN = N / BM; nwg = nM * nN; G = G_; c = c_; }
    __host__ __device__ bool next(int i, Unit& u) const {
        const long L = (long)i * G + c; if (L >= nwg) return false;
        int wgid = (int)L; { const int q = nwg / NXCD, r = nwg % NXCD, xcd = wgid % NXCD, off = wgid / NXCD; wgid = (xcd < r ? xcd * (q + 1) : r * (q + 1) + (xcd - r) * q) + off; }
        const int nig = WGM * nN, gid = wgid / nig, fm = gid * WGM, gsz = (nM - fm) < WGM ? (nM - fm) : WGM;
        u.pm = fm + ((wgid % nig) % gsz); u.pn = (wgid % nig) / gsz; return true;
    }
};

template <class Epi, bool FUSED = false>
__device__ __forceinline__ void gemm_phase(LAS unsigned char* lds, const Gemm g, const StaticOrder& S, const Epi& E) {
    const int tid = threadIdx.x, wid = __builtin_amdgcn_readfirstlane(tid >> 6), lane = tid & 63, wr = wid >> 2, wc = wid & 3, fr = lane & 15, fq = lane >> 4;
    const int K = g.K, nt = K / BK;
    unsigned voffA[2], voffB[2];
#pragma unroll
    for (int i = 0; i < 2; ++i) { int R, C; stage_rc(tid * 16 + i * 8192, R, C); const int Rb = (R & ~31) + perm32(R & 31);
        voffA[i] = (unsigned)(R * g.lda + C) * 2u; voffB[i] = (unsigned)(Rb * g.ldb + C) * 2u; }
    const size_t kstep = (size_t)(BK * 2);
    const size_t hstepA = (size_t)HALF * g.lda * 2, hstepB = (size_t)HALF * g.ldb * 2;
    const size_t tstepA = 2 * hstepA, tstepB = 2 * hstepB;
    const unsigned ldsw = (unsigned)wid * 1024u;
    const int aoff = lds_byte(wr * 64 + fr, fq * 8), boff = lds_byte(wc * 32 + fr, fq * 8);
#define PG8_SA(b, h) (((b) * 2 + (h)) * HTB)
#define PG8_SB(b, h) ((4 + (b) * 2 + (h)) * HTB)
#define PG8_STAGE(bufoff, gbase, voff) do { _Pragma("unroll") for (int _i = 0; _i < 2; ++_i) \
        __builtin_amdgcn_global_load_lds((const unsigned*)((const char*)(gbase) + (voff)[_i]), (LAS unsigned*)(lds + (bufoff) + ldsw + _i * 8192), 16, 0, 0); } while (0)
#define PG8_LDA(dst, b, h) do { _Pragma("unroll") for (int m = 0; m < 4; ++m) _Pragma("unroll") for (int k = 0; k < 2; ++k) dst[m][k] = *(const LAS bf16x8*)(lds + PG8_SA(b, h) + aoff + m * 2048 + k * 1024); } while (0)
#define PG8_LDB(dst, b, h) do { _Pragma("unroll") for (int n = 0; n < 2; ++n) _Pragma("unroll") for (int k = 0; k < 2; ++k) dst[n][k] = *(const LAS bf16x8*)(lds + PG8_SB(b, h) + boff + n * 2048 + k * 1024); } while (0)
#define PG8_MMA(ai, bj, At, Bt) do { __builtin_amdgcn_s_setprio(1); _Pragma("unroll") for (int m = 0; m < 4; ++m) _Pragma("unroll") for (int n = 0; n < 2; ++n) _Pragma("unroll") for (int k = 0; k < 2; ++k) \
        acc[ai][bj][m][n] = __builtin_amdgcn_mfma_f32_16x16x32_bf16(Bt[n][k], At[m][k], acc[ai][bj][m][n], 0, 0, 0); __builtin_amdgcn_s_setprio(0); } while (0)
#define PG8_WAIT_V(n) asm volatile("s_waitcnt vmcnt(" #n ")" ::: "memory")
#define PG8_WAIT_L(n) asm volatile("s_waitcnt lgkmcnt(" #n ")" ::: "memory")
#define PG8_BAR __builtin_amdgcn_s_barrier()
#define PG8_SCHED __builtin_amdgcn_sched_barrier(0)
    Unit cur, nxt; int ui = 0;
    if (!S.next(0, cur)) return;
    f32x4 acc[2][2][4][2];
#pragma unroll
    for (int a = 0; a < 2; ++a)
#pragma unroll
        for (int b = 0; b < 2; ++b)
#pragma unroll
            for (int m = 0; m < 4; ++m)
#pragma unroll
                for (int n = 0; n < 2; ++n) acc[a][b][m][n] = (f32x4){0.f, 0.f, 0.f, 0.f};
    bf16x8 At[4][2], B0[2][2], B1[2][2];
    const char* cA = (const char*)g.A + (size_t)cur.pm * tstepA; const char* cB = (const char*)g.Bt + (size_t)cur.pn * tstepB;
    PG8_STAGE(PG8_SB(0, 0), cB, voffB); PG8_STAGE(PG8_SB(0, 1), cB + hstepB, voffB); PG8_STAGE(PG8_SA(0, 0), cA, voffA); PG8_STAGE(PG8_SA(0, 1), cA + hstepA, voffA);
    if (wr == 1) PG8_BAR;
    PG8_WAIT_V(2); PG8_BAR;
    PG8_STAGE(PG8_SB(1, 0), cB + kstep, voffB); PG8_STAGE(PG8_SA(1, 0), cA + kstep, voffA); PG8_STAGE(PG8_SB(1, 1), cB + hstepB + kstep, voffB);
    PG8_WAIT_V(6); PG8_BAR;
    for (;;) {
        const bool has_next = S.next(ui + 1, nxt);
        const char* nA = has_next ? (const char*)g.A + (size_t)nxt.pm * tstepA : cA; const char* nB = has_next ? (const char*)g.Bt + (size_t)nxt.pn * tstepB : cB;
        for (int t = 0; t < nt; t += 2) {
            const bool last = (t == nt - 2);
            const char* a1 = cA + (size_t)(t + 1) * kstep;
            const char* a2 = last ? nA : cA + (size_t)(t + 2) * kstep; const char* b2 = last ? nB : cB + (size_t)(t + 2) * kstep;
            const char* a3 = a2 + kstep; const char* b3 = b2 + kstep;
            PG8_LDB(B0, 0, 0); PG8_LDB(B1, 0, 1); PG8_SCHED; PG8_LDA(At, 0, 0); PG8_STAGE(PG8_SA(1, 1), a1 + hstepA, voffA);
            PG8_WAIT_V(8); PG8_WAIT_L(0); PG8_BAR; PG8_MMA(0, 0, At, B0); PG8_MMA(0, 1, At, B1); PG8_BAR; PG8_SCHED;
            PG8_LDA(At, 0, 1); PG8_STAGE(PG8_SB(0, 0), b2, voffB); PG8_STAGE(PG8_SB(0, 1), b2 + hstepB, voffB); PG8_STAGE(PG8_SA(0, 0), a2, voffA);
            PG8_WAIT_V(8); PG8_WAIT_L(0); PG8_BAR; PG8_MMA(1, 0, At, B0); PG8_MMA(1, 1, At, B1); PG8_BAR; PG8_SCHED;
            PG8_LDB(B0, 1, 0); PG8_LDB(B1, 1, 1); PG8_SCHED; PG8_LDA(At, 1, 0); PG8_STAGE(PG8_SA(0, 1), a2 + hstepA, voffA);
            PG8_WAIT_V(8); PG8_WAIT_L(0); PG8_BAR; PG8_MMA(0, 0, At, B0); PG8_MMA(0, 1, At, B1); PG8_BAR; PG8_SCHED;
            PG8_LDA(At, 1, 1); PG8_STAGE(PG8_SB(1, 0), b3, voffB); PG8_STAGE(PG8_SB(1, 1), b3 + hstepB, voffB); PG8_STAGE(PG8_SA(1, 0), a3, voffA);
            PG8_WAIT_V(8); PG8_WAIT_L(0); PG8_BAR; PG8_MMA(1, 0, At, B0); PG8_MMA(1, 1, At, B1); PG8_BAR; PG8_SCHED;
        }
        if (wr == 0) PG8_BAR;
        if constexpr (!FUSED) E(acc, cur, wr, wc, fr, fq);
        if (!has_next) break;
#pragma unroll
        for (int a = 0; a < 2; ++a)
#pragma unroll
            for (int b = 0; b < 2; ++b)
#pragma unroll
                for (int m = 0; m < 4; ++m)
#pragma unroll
                    for (int n = 0; n < 2; ++n) acc[a][b][m][n] = (f32x4){0.f, 0.f, 0.f, 0.f};
        cur = nxt; cA = nA; cB = nB; ++ui;
        if (wr == 1) PG8_BAR;
    }
    PG8_WAIT_V(0);
    PG8_BAR;
    if constexpr (FUSED) E.fused(acc, cur, wr, wc, fr, fq, lds);
#undef PG8_SA
#undef PG8_SB
#undef PG8_STAGE
#undef PG8_LDA
#undef PG8_LDB
#undef PG8_MMA
#undef PG8_WAIT_V
#undef PG8_WAIT_L
#undef PG8_BAR
#undef PG8_SCHED
}
}
using pg8::Unit;
typedef f32x4 AccT[2][2][4][2];

struct EpiUp {
    const float* rs_single; const float* part; bf16_t* act;
    __device__ __forceinline__ void operator()(const AccT& acc, const Unit& u, int wr, int wc, int fr, int fq) const {
#pragma unroll
        for (int ai = 0; ai < 2; ++ai)
#pragma unroll
            for (int m = 0; m < 4; ++m) {
                const int row = u.pm * 256 + ai * 128 + wr * 64 + m * 16 + fr;
                const float rs = rs_single ? rs_single[row] : rs_from_part4(part, row, fq);
                const int f0 = u.pn * 128 + wc * 32 + fq * 8;
                const f32x4 g0 = acc[ai][0][m][0] * rs, g1 = acc[ai][0][m][1] * rs, u0 = acc[ai][1][m][0] * rs, u1 = acc[ai][1][m][1] * rs;
                u32x4 w; w.x = cvt_pk_bf16(siluf(g0[0]) * u0[0], siluf(g0[1]) * u0[1]); w.y = cvt_pk_bf16(siluf(g0[2]) * u0[2], siluf(g0[3]) * u0[3]);
                w.z = cvt_pk_bf16(siluf(g1[0]) * u1[0], siluf(g1[1]) * u1[1]); w.w = cvt_pk_bf16(siluf(g1[2]) * u1[2], siluf(g1[3]) * u1[3]);
                *(u32x4*)(act + (size_t)row * FF + f0) = w;
            }
    }
};
struct EpiRes {
    Params P; float scale; int first; bf16_t* xb; float* part;
    __device__ __forceinline__ void operator()(const AccT& acc, const Unit& u, int wr, int wc, int fr, int fq) const {
#pragma unroll
        for (int ai = 0; ai < 2; ++ai)
#pragma unroll
            for (int m = 0; m < 4; ++m) {
                const int row = u.pm * 256 + ai * 128 + wr * 64 + m * 16 + fr;
                float* xn = xres_row(P, row);
                const float* xo = first ? xin_row(P, row) : xn;
                float ss = 0.f;
#pragma unroll
                for (int bj = 0; bj < 2; ++bj) {
                    const int c0 = u.pn * 256 + bj * 128 + wc * 32 + fq * 8;
                    f32x4 o0 = (f32x4){0.f, 0.f, 0.f, 0.f}, o1 = o0;
                    if (xo) { o0 = *(const f32x4*)(xo + c0); o1 = *(const f32x4*)(xo + c0 + 4); }
                    const f32x4 v0 = o0 + acc[ai][bj][m][0] * scale, v1 = o1 + acc[ai][bj][m][1] * scale;
                    *(f32x4*)(xn + c0) = v0; *(f32x4*)(xn + c0 + 4) = v1;
                    ss += ((v0[0] * v0[0] + v0[1] * v0[1]) + (v0[2] * v0[2] + v0[3] * v0[3])) + ((v1[0] * v1[0] + v1[1] * v1[1]) + (v1[2] * v1[2] + v1[3] * v1[3]));
                    if (xb) { u32x4 w; w.x = cvt_pk_bf16(v0[0], v0[1]); w.y = cvt_pk_bf16(v0[2], v0[3]); w.z = cvt_pk_bf16(v1[0], v1[1]); w.w = cvt_pk_bf16(v1[2], v1[3]);
                        *(u32x4*)(xb + (size_t)row * D + c0) = w; }
                }
                ss += __shfl_xor(ss, 16); ss += __shfl_xor(ss, 32);
                if (fq == 0) part[(size_t)row * 16 + u.pn * 4 + wc] = ss;
            }
    }
    __device__ __forceinline__ float tail4(int row, int c0, f32x4 a) const {
        float* xn = xres_row(P, row);
        const float* xo = first ? xin_row(P, row) : xn;
        f32x4 o = (f32x4){0.f, 0.f, 0.f, 0.f};
        if (xo) o = *(const f32x4*)(xo + c0);
        const f32x4 v = o + a * scale;
        *(f32x4*)(xn + c0) = v;
        if (xb) { u32x2 w; w.x = cvt_pk_bf16(v[0], v[1]); w.y = cvt_pk_bf16(v[2], v[3]); *(u32x2*)(xb + (size_t)row * D + c0) = w; }
        return (v[0] * v[0] + v[1] * v[1]) + (v[2] * v[2] + v[3] * v[3]);
    }
    __device__ __forceinline__ void tail_row(int row, int cb, float ss, int fq) const { if (fq == 0) part[(size_t)row * 16 + cb] = ss; }
};
struct EpiQkv {
    Params P; const float* part;
    __device__ __forceinline__ void operator()(const AccT& acc, const Unit& u, int wr, int wc, int fr, int fq) const {
        unsigned char* ws = P.ws;
        if (u.pn < 12) {
            const int which = u.pn >> 2;
            bf16_t* buf = (bf16_t*)(ws + OFF_S0 + (size_t)which * U1);
#pragma unroll
            for (int ai = 0; ai < 2; ++ai)
#pragma unroll
                for (int m = 0; m < 4; ++m) {
                    const int row = u.pm * 256 + ai * 128 + wr * 64 + m * 16 + fr;
                    const float rs = rs_from_part4(part, row, fq);
                    bf16_t* halo = nullptr; float* fout = nullptr;
                    if (row < ROW_SAMPLE) { const int b = row >> 11, s = row & 2047, m64 = s & 63;
                        if (m64 >= 61) { const int c = (s >> 6) + 2, d = m64 - 61;
                            if (c <= 32) halo = (bf16_t*)(ws + OFF_HALO) + (size_t)((b * 33 + c) * 3 + d) * 3072;
                            else fout = P.out + O_PGC + (size_t)(b * 3 + d) * 3072; } }
                    else if (row < ROW_META) { const int i = (row - ROW_SAMPLE) >> 3, t = row & 7; if (t >= 5) fout = P.out + O_SGC + (size_t)(i * 3 + (t - 5)) * 3072; }
                    else if (row < TREAL) { const int b = (row - ROW_META) >> 4, mm = row & 15; if (mm >= 13) halo = (bf16_t*)(ws + OFF_HALO) + (size_t)((b * 33 + 1) * 3 + (mm - 13)) * 3072; }
#pragma unroll
                    for (int bj = 0; bj < 2; ++bj) {
                        const int c0 = (u.pn & 3) * 256 + bj * 128 + wc * 32 + fq * 8;
                        const f32x4 v0 = acc[ai][bj][m][0] * rs, v1 = acc[ai][bj][m][1] * rs;
                        u32x4 w; w.x = cvt_pk_bf16(v0[0], v0[1]); w.y = cvt_pk_bf16(v0[2], v0[3]); w.z = cvt_pk_bf16(v1[0], v1[1]); w.w = cvt_pk_bf16(v1[2], v1[3]);
                        *(u32x4*)(buf + (size_t)row * D + c0) = w;
                        if (halo) *(u32x4*)(halo + which * 1024 + c0) = w;
                        if (fout) { *(f32x4*)(fout + which * 1024 + c0) = v0; *(f32x4*)(fout + which * 1024 + c0 + 4) = v1; }
                    }
                }
        } else {
            float* ab = (float*)(ws + OFF_AB);
            if (wc == 0 && fq < 2) {
#pragma unroll
                for (int ai = 0; ai < 2; ++ai)
#pragma unroll
                    for (int m = 0; m < 4; ++m) {
                        const int row = u.pm * 256 + ai * 128 + wr * 64 + m * 16 + fr;
                        const float rs = rs_from_part(part, row);
                        *(f32x4*)(ab + (size_t)row * 16 + fq * 8) = acc[ai][0][m][0] * rs;
                        *(f32x4*)(ab + (size_t)row * 16 + fq * 8 + 4) = acc[ai][0][m][1] * rs;
                    }
            }
        }
    }
};
struct EpiSc {
    Params P; const float* part;
    __device__ __forceinline__ void operator()(const AccT& acc, const Unit& u, int wr, int wc, int fr, int fq) const {
        unsigned char* ws = P.ws;
        bf16_t* pbuf = (bf16_t*)(ws + OFF_S0); bf16_t* scb = (bf16_t*)(ws + OFF_S1); bf16_t* sga = (bf16_t*)(ws + OFF_S3);
        const bool isp = u.pn < 8; const int pn8 = u.pn & 7;
#pragma unroll
        for (int ai = 0; ai < 2; ++ai)
#pragma unroll
            for (int m = 0; m < 4; ++m) {
                const int row = u.pm * 256 + ai * 128 + wr * 64 + m * 16 + fr;
                const float rs = rs_from_part4(part, row, fq);
                const int ch0 = pn8 * 128 + wc * 32 + fq * 8;
                const f32x4 a0 = acc[ai][0][m][0] * rs, a1 = acc[ai][0][m][1] * rs, b0 = acc[ai][1][m][0] * rs, b1 = acc[ai][1][m][1] * rs;
                if (isp) {
                    float* fout = nullptr;
                    if (row < ROW_SAMPLE) { const int b = row >> 11, s = row & 2047; if (s >= 2046) fout = P.out + O_PSC + (size_t)(b * 2 + (s - 2046)) * 1024; }
                    else if (row < ROW_META) { const int i = (row - ROW_SAMPLE) >> 3, t = row & 7; if (t >= 6) fout = P.out + O_SSC + (size_t)(i * 2 + (t - 6)) * 1024; }
                    const f32x4 p0 = a0 * b0, p1 = a1 * b1;
                    u32x4 w; w.x = cvt_pk_bf16(p0[0], p0[1]); w.y = cvt_pk_bf16(p0[2], p0[3]); w.z = cvt_pk_bf16(p1[0], p1[1]); w.w = cvt_pk_bf16(p1[2], p1[3]);
                    *(u32x4*)(pbuf + (size_t)row * D + ch0) = w;
                    if (fout) { *(f32x4*)(fout + ch0) = p0; *(f32x4*)(fout + ch0 + 4) = p1; }
                } else {
                    u32x4 w; w.x = cvt_pk_bf16(a0[0], a0[1]); w.y = cvt_pk_bf16(a0[2], a0[3]); w.z = cvt_pk_bf16(a1[0], a1[1]); w.w = cvt_pk_bf16(a1[2], a1[3]);
                    *(u32x4*)(scb + (size_t)row * D + ch0) = w;
                    u32x4 g; g.x = cvt_pk_bf16(sigm(b0[0]), sigm(b0[1])); g.y = cvt_pk_bf16(sigm(b0[2]), sigm(b0[3])); g.z = cvt_pk_bf16(sigm(b1[0]), sigm(b1[1])); g.w = cvt_pk_bf16(sigm(b1[2]), sigm(b1[3]));
                    *(u32x4*)(sga + (size_t)row * D + ch0) = g;
                }
            }
    }
};
struct EpiZg {
    Params P; const float* part;
    __device__ __forceinline__ void operator()(const AccT& acc, const Unit& u, int wr, int wc, int fr, int fq) const {
        unsigned char* ws = P.ws;
        bf16_t* yb = (bf16_t*)(ws + OFF_S2); bf16_t* sgb = (bf16_t*)(ws + OFF_S0);
#pragma unroll
        for (int ai = 0; ai < 2; ++ai)
#pragma unroll
            for (int m = 0; m < 4; ++m) {
                const int row = u.pm * 256 + ai * 128 + wr * 64 + m * 16 + fr;
                const float rs = rs_from_part4(part, row, fq);
                const int cl = wc * 32 + fq * 8, ch0 = u.pn * 128 + cl;
                const f32x4 z0 = acc[ai][0][m][0] * rs, z1 = acc[ai][0][m][1] * rs, g0 = acc[ai][1][m][0] * rs, g1 = acc[ai][1][m][1] * rs;
                const u32x4 o = *(const u32x4*)(yb + (size_t)row * D + ch0);
                const f32x4* sp = (const f32x4*)((const float*)(ws + OFF_SSQ) + (size_t)row * 64 + u.pn * 8);
                const f32x4 q0 = sp[0], q1 = sp[1];
                const float rn = rsqrtf((((q0.x + q0.y) + (q0.z + q0.w)) + ((q1.x + q1.y) + (q1.z + q1.w))) * (1.f / 128.f) + EPS);
                const f32x4 n0 = *(const f32x4*)(P.in[16] + cl) * rn, n1 = *(const f32x4*)(P.in[16] + cl + 4) * rn;
                u32x4 w; w.x = cvt_pk_bf16(bf_lo(o.x) * n0.x * siluf(z0[0]), bf_hi(o.x) * n0.y * siluf(z0[1])); w.y = cvt_pk_bf16(bf_lo(o.y) * n0.z * siluf(z0[2]), bf_hi(o.y) * n0.w * siluf(z0[3]));
                w.z = cvt_pk_bf16(bf_lo(o.z) * n1.x * siluf(z1[0]), bf_hi(o.z) * n1.y * siluf(z1[1])); w.w = cvt_pk_bf16(bf_lo(o.w) * n1.z * siluf(z1[2]), bf_hi(o.w) * n1.w * siluf(z1[3]));
                *(u32x4*)(yb + (size_t)row * D + ch0) = w;
                u32x4 g; g.x = cvt_pk_bf16(sigm(g0[0]), sigm(g0[1])); g.y = cvt_pk_bf16(sigm(g0[2]), sigm(g0[3])); g.z = cvt_pk_bf16(sigm(g1[0]), sigm(g1[1])); g.w = cvt_pk_bf16(sigm(g1[2]), sigm(g1[3]));
                *(u32x4*)(sgb + (size_t)row * D + ch0) = g;
            }
    }
};
struct EpiGate {
    bf16_t* dst; const bf16_t* gate; int addprev;
    __device__ __forceinline__ void operator()(const AccT& acc, const Unit& u, int wr, int wc, int fr, int fq) const {
#pragma unroll
        for (int ai = 0; ai < 2; ++ai)
#pragma unroll
            for (int m = 0; m < 4; ++m) {
                const int row = u.pm * 256 + ai * 128 + wr * 64 + m * 16 + fr;
#pragma unroll
                for (int bj = 0; bj < 2; ++bj) {
                    const int c0 = u.pn * 256 + bj * 128 + wc * 32 + fq * 8;
                    const u32x4 gt = *(const u32x4*)(gate + (size_t)row * D + c0);
                    const f32x4 a0 = acc[ai][bj][m][0], a1 = acc[ai][bj][m][1];
                    float r[8] = {bf_lo(gt.x) * a0[0], bf_hi(gt.x) * a0[1], bf_lo(gt.y) * a0[2], bf_hi(gt.y) * a0[3], bf_lo(gt.z) * a1[0], bf_hi(gt.z) * a1[1], bf_lo(gt.w) * a1[2], bf_hi(gt.w) * a1[3]};
                    if (addprev) { const u32x4 pv = *(const u32x4*)(dst + (size_t)row * D + c0);
                        r[0] += bf_lo(pv.x); r[1] += bf_hi(pv.x); r[2] += bf_lo(pv.y); r[3] += bf_hi(pv.y); r[4] += bf_lo(pv.z); r[5] += bf_hi(pv.z); r[6] += bf_lo(pv.w); r[7] += bf_hi(pv.w); }
                    u32x4 w; w.x = cvt_pk_bf16(r[0], r[1]); w.y = cvt_pk_bf16(r[2], r[3]); w.z = cvt_pk_bf16(r[4], r[5]); w.w = cvt_pk_bf16(r[6], r[7]);
                    *(u32x4*)(dst + (size_t)row * D + c0) = w;
                }
            }
    }
    __device__ __forceinline__ float tail4(int row, int c0, f32x4 a) const {
        const u32x2 gt = *(const u32x2*)(gate + (size_t)row * D + c0);
        float r0 = bf_lo(gt.x) * a[0], r1 = bf_hi(gt.x) * a[1], r2 = bf_lo(gt.y) * a[2], r3 = bf_hi(gt.y) * a[3];
        if (addprev) { const u32x2 pv = *(const u32x2*)(dst + (size_t)row * D + c0); r0 += bf_lo(pv.x); r1 += bf_hi(pv.x); r2 += bf_lo(pv.y); r3 += bf_hi(pv.y); }
        u32x2 w; w.x = cvt_pk_bf16(r0, r1); w.y = cvt_pk_bf16(r2, r3);
        *(u32x2*)(dst + (size_t)row * D + c0) = w;
        return 0.f;
    }
    __device__ __forceinline__ void tail_row(int, int, float, int) const {}
};

struct EpiFinal {
    float* xio; const float* gfin; unsigned char* ws;
    __device__ __forceinline__ void operator()(const AccT&, const Unit&, int, int, int, int) const {}
    __device__ __forceinline__ void fused(AccT& acc, const Unit& u, int wr, int wc, int fr, int fq, LAS unsigned char* lds) const {
        LAS float* red = (LAS float*)lds;
        LAS float* rtab = (LAS float*)(lds + 4096);
        const int tid = threadIdx.x;
#pragma unroll
        for (int ai = 0; ai < 2; ++ai)
#pragma unroll
            for (int m = 0; m < 4; ++m) {
                const int rl = ai * 128 + wr * 64 + m * 16 + fr;
                const float* xr = xio + (size_t)(u.pm * 256 + rl) * D;
                float ss = 0.f;
#pragma unroll
                for (int bj = 0; bj < 2; ++bj) {
                    const int c0 = u.pn * 256 + bj * 128 + wc * 32 + fq * 8;
                    const f32x4 v0 = *(const f32x4*)(xr + c0) + acc[ai][bj][m][0] * 0.5f, v1 = *(const f32x4*)(xr + c0 + 4) + acc[ai][bj][m][1] * 0.5f;
                    acc[ai][bj][m][0] = v0; acc[ai][bj][m][1] = v1;
                    ss += ((v0[0] * v0[0] + v0[1] * v0[1]) + (v0[2] * v0[2] + v0[3] * v0[3])) + ((v1[0] * v1[0] + v1[1] * v1[1]) + (v1[2] * v1[2] + v1[3] * v1[3]));
                }
                ss += __shfl_xor(ss, 16); ss += __shfl_xor(ss, 32);
                if (fq == 0) red[rl * 4 + wc] = ss;
            }
        __syncthreads();
        unsigned* xch = (unsigned*)(ws + OFF_FINX) + (size_t)(u.pm * 4) * 256;
        if (tid < 256) { const f32x4 q = *(const LAS f32x4*)(red + tid * 4);
            __hip_atomic_store(xch + u.pn * 256 + tid, __builtin_bit_cast(unsigned, (q.x + q.y) + (q.z + q.w)), __ATOMIC_RELAXED, __HIP_MEMORY_SCOPE_AGENT); }
        asm volatile("s_waitcnt vmcnt(0)" ::: "memory");
        __syncthreads();
        if (tid == 0) {
            unsigned* cnt = (unsigned*)(ws + OFF_CTL) + CW_FIN + u.pm;
            __hip_atomic_fetch_add(cnt, 1u, __ATOMIC_RELAXED, __HIP_MEMORY_SCOPE_AGENT);
            unsigned sp = 0;
            while (__hip_atomic_load(cnt, __ATOMIC_RELAXED, __HIP_MEMORY_SCOPE_AGENT) < 4u) { __builtin_amdgcn_s_sleep(1); if (++sp > (1u << 22)) break; }
            __builtin_amdgcn_fence(__ATOMIC_ACQUIRE, "agent");
            asm volatile("s_waitcnt vmcnt(0)" ::: "memory");
        }
        __syncthreads();
        if (tid < 256) {
            float tot = 0.f;
#pragma unroll
            for (int j = 0; j < 4; ++j) tot += __builtin_bit_cast(float, __hip_atomic_load(xch + j * 256 + tid, __ATOMIC_RELAXED, __HIP_MEMORY_SCOPE_AGENT));
            rtab[tid] = rsqrtf(tot * (1.f / 1024.f) + EPS);
        }
        __syncthreads();
#pragma unroll
        for (int ai = 0; ai < 2; ++ai)
#pragma unroll
            for (int m = 0; m < 4; ++m) {
                const int rl = ai * 128 + wr * 64 + m * 16 + fr;
                const float r = rtab[rl];
                float* yr = xio + (size_t)(u.pm * 256 + rl) * D;
#pragma unroll
                for (int bj = 0; bj < 2; ++bj) {
                    const int c0 = u.pn * 256 + bj * 128 + wc * 32 + fq * 8;
                    *(f32x4*)(yr + c0) = acc[ai][bj][m][0] * r * *(const f32x4*)(gfin + c0);
                    *(f32x4*)(yr + c0 + 4) = acc[ai][bj][m][1] * r * *(const f32x4*)(gfin + c0 + 4);
                }
            }
    }
};

template <int MODE, int NCB = 16>
__device__ __forceinline__ void gemm_tail(const Params& P, LAS unsigned char* lds, const bf16_t* A, const int lda, const bf16_t* Bt, const int K,
                                          const float scale, const int first, bf16_t* xb, float* part, bf16_t* dst, const bf16_t* gate, const int addprev) {
    const int tid = threadIdx.x, wid = __builtin_amdgcn_readfirstlane(tid >> 6), lane = tid & 63, fr = lane & 15, fq = lane >> 4;
    constexpr int TP2 = 136;
    LAS bf16_t* Al = (LAS bf16_t*)lds;
    LAS bf16_t* Bl = (LAS bf16_t*)(lds + 2 * 80 * TP2 * 2);
    LAS float* ssum = (LAS float*)(lds + 2 * 80 * TP2 * 2 + 2 * 64 * TP2 * 2);
    const int nt = wid < 4 ? 3 : 2;
    const int nch = K / 128;
    constexpr int UPC = NCB / 16;
#pragma unroll 1
    for (int tu0 = blockIdx.x * UPC; tu0 < 16 * NCB; tu0 += gridDim.x * UPC)
#pragma unroll 1
    for (int tu = tu0; tu < tu0 + UPC; ++tu) {
        const int rb = tu / NCB, cb = tu % NCB;
        const int row0 = ROW_SAMPLE + rb * 80;
        const bf16_t* ga[3]; const bf16_t* gb[2];
#pragma unroll
        for (int j = 0; j < 3; ++j) { const int pz = tid + 512 * j; ga[j] = A + (size_t)(row0 + ((pz < 1280 ? pz : 0) >> 4)) * lda + (pz & 15) * 8; }
#pragma unroll
        for (int j = 0; j < 2; ++j) { const int pz = tid + 512 * j; gb[j] = Bt + (size_t)(cb * 64 + (pz >> 4)) * K + (pz & 15) * 8; }
        u32x4 ra[3], rbv[2];
#pragma unroll
        for (int j = 0; j < 3; ++j) ra[j] = *(const u32x4*)(ga[j]);
#pragma unroll
        for (int j = 0; j < 2; ++j) rbv[j] = *(const u32x4*)(gb[j]);
        f32x4 acc[3];
#pragma unroll
        for (int j = 0; j < 3; ++j) acc[j] = (f32x4){0.f, 0.f, 0.f, 0.f};
#pragma unroll 1
        for (int ch = 0; ch < nch; ++ch) {
            LAS bf16_t* Ab = Al + (ch & 1) * 80 * TP2; LAS bf16_t* Bb = Bl + (ch & 1) * 64 * TP2;
#pragma unroll
            for (int j = 0; j < 3; ++j) { const int pz = tid + 512 * j; if (pz < 1280) *(LAS u32x4*)(Ab + (pz >> 4) * TP2 + (pz & 15) * 8) = ra[j]; }
#pragma unroll
            for (int j = 0; j < 2; ++j) { const int pz = tid + 512 * j; *(LAS u32x4*)(Bb + (pz >> 4) * TP2 + (pz & 15) * 8) = rbv[j]; }
            if (ch + 1 < nch) {
#pragma unroll
                for (int j = 0; j < 3; ++j) ra[j] = *(const u32x4*)(ga[j] + (size_t)(ch + 1) * 128);
#pragma unroll
                for (int j = 0; j < 2; ++j) rbv[j] = *(const u32x4*)(gb[j] + (size_t)(ch + 1) * 128);
            }
            asm volatile("s_waitcnt lgkmcnt(0)" ::: "memory"); __builtin_amdgcn_s_barrier(); asm volatile("" ::: "memory");
#pragma unroll
            for (int ks = 0; ks < 4; ++ks) {
#pragma unroll
                for (int j = 0; j < 3; ++j) {
                    if (j < nt) { const int t = wid + 8 * j, rt = t >> 2, ct = t & 3;
                        const bf16x8 a = *(const LAS bf16x8*)(Bb + (16 * ct + fr) * TP2 + 32 * ks + 8 * fq);
                        const bf16x8 b = *(const LAS bf16x8*)(Ab + (16 * rt + fr) * TP2 + 32 * ks + 8 * fq);
                        acc[j] = __builtin_amdgcn_mfma_f32_16x16x32_bf16(a, b, acc[j], 0, 0, 0); }
                }
            }
        }
#pragma unroll
        for (int j = 0; j < 3; ++j) {
            if (j < nt) {
                const int t = wid + 8 * j, rt = t >> 2, ct = t & 3;
                const int row = row0 + 16 * rt + fr, c0 = cb * 64 + 16 * ct + 4 * fq;
                if (MODE == 0) {
                    float* xn = xres_row(P, row);
                    const float* xo = first ? xin_row(P, row) : xn;
                    f32x4 o = (f32x4){0.f, 0.f, 0.f, 0.f};
                    if (xo) o = *(const f32x4*)(xo + c0);
                    const f32x4 v = o + acc[j] * scale;
                    *(f32x4*)(xn + c0) = v;
                    if (xb) { u32x2 w; w.x = cvt_pk_bf16(v[0], v[1]); w.y = cvt_pk_bf16(v[2], v[3]); *(u32x2*)(xb + (size_t)row * D + c0) = w; }
                    float ss = (v[0] * v[0] + v[1] * v[1]) + (v[2] * v[2] + v[3] * v[3]);
                    ss += __shfl_xor(ss, 16); ss += __shfl_xor(ss, 32);
                    if (fq == 0) ssum[(16 * rt + fr) * 4 + ct] = ss;
                } else if (MODE == 2) {
                    const int ch0 = (cb >> 2) * 128 + (cb & 1) * 64 + 16 * ct + 4 * fq;
                    const float rs = rs_from_part4(part, row, fq);
                    const f32x4 val = acc[j] * rs;
                    if (((cb >> 1) & 1) == 0) {
                        const u32x2 o = *(const u32x2*)(dst + (size_t)row * D + ch0);
                        const f32x4* sp = (const f32x4*)((const float*)(P.ws + OFF_SSQ) + (size_t)row * 64 + (ch0 >> 7) * 8);
                        const f32x4 q0 = sp[0], q1 = sp[1];
                        const float rn = rsqrtf((((q0.x + q0.y) + (q0.z + q0.w)) + ((q1.x + q1.y) + (q1.z + q1.w))) * (1.f / 128.f) + EPS);
                        const f32x4 gn = *(const f32x4*)(P.in[16] + (ch0 & 127)) * rn;
                        u32x2 w; w.x = cvt_pk_bf16(bf_lo(o.x) * gn.x * siluf(val[0]), bf_hi(o.x) * gn.y * siluf(val[1])); w.y = cvt_pk_bf16(bf_lo(o.y) * gn.z * siluf(val[2]), bf_hi(o.y) * gn.w * siluf(val[3]));
                        *(u32x2*)(dst + (size_t)row * D + ch0) = w;
                    } else {
                        u32x2 g; g.x = cvt_pk_bf16(sigm(val[0]), sigm(val[1])); g.y = cvt_pk_bf16(sigm(val[2]), sigm(val[3]));
                        *(u32x2*)(xb + (size_t)row * D + ch0) = g;
                    }
                } else {
                    const u32x2 gt = *(const u32x2*)(gate + (size_t)row * D + c0);
                    float r0 = bf_lo(gt.x) * acc[j][0], r1 = bf_hi(gt.x) * acc[j][1], r2 = bf_lo(gt.y) * acc[j][2], r3 = bf_hi(gt.y) * acc[j][3];
                    if (addprev) { const u32x2 pv = *(const u32x2*)(dst + (size_t)row * D + c0); r0 += bf_lo(pv.x); r1 += bf_hi(pv.x); r2 += bf_lo(pv.y); r3 += bf_hi(pv.y); }
                    u32x2 w; w.x = cvt_pk_bf16(r0, r1); w.y = cvt_pk_bf16(r2, r3);
                    *(u32x2*)(dst + (size_t)row * D + c0) = w;
                }
            }
        }
        __syncthreads();
        if (MODE == 0 && tid < 80) part[(size_t)(row0 + tid) * 16 + cb] = (ssum[tid * 4] + ssum[tid * 4 + 1]) + (ssum[tid * 4 + 2] + ssum[tid * 4 + 3]);
        __syncthreads();
    }
}

__device__ __forceinline__ const float* wcol(const Params& P, int mat, int v, int& ld, const float*& gain) {
    gain = nullptr;
    if (mat == 0 || mat == 8) { const int n = (v >> 7) & 1, f = ((v >> 8) << 7) + (v & 127); ld = FF; gain = P.in[mat == 0 ? 6 : 20];
        return (mat == 0 ? (n ? P.in[8] : P.in[7]) : (n ? P.in[22] : P.in[21])) + f; }
    if (mat == 1) { ld = D; return P.in[9] + v; }
    if (mat == 9) { ld = D; return P.in[23] + v; }
    if (mat == 2) { ld = INC; gain = P.in[10]; if (v < 3072) return P.in[11] + 3072 + v; if (v < 3088) return P.in[11] + 6144 + (v - 3072); return nullptr; }
    if (mat == 3) { ld = INC; gain = P.in[10]; const int vv = v & 2047, n = (vv >> 7) & 1, ch = ((vv >> 8) << 7) + (vv & 127);
        const int col = (v < 2048) ? (n ? 2048 + ch : 1024 + ch) : (n ? 7184 + ch : ch); return P.in[11] + col; }
    if (mat == 4) { ld = INC; gain = P.in[10]; const int n = (v >> 7) & 1, ch = ((v >> 8) << 7) + (v & 127); return P.in[11] + (n ? 8208 + ch : 6160 + ch); }
    ld = D;
    if (mat == 5) return P.in[17] + v;
    if (mat == 6) return P.in[18] + v;
    return P.in[19] + v;
}
__device__ __forceinline__ void conv_item(const Params& P, int mat, int Nv, int K, bf16_t* WT, int item, LAS float* scr, int lane) {
    const int nblk = Nv / 32, kb = item / nblk, nb = item % nblk, k0 = 64 * kb, n0 = 32 * nb;
    int ld; const float* gain; const float* src = wcol(P, mat, n0 + (lane & 31), ld, gain);
    float vals[32];
#pragma unroll
    for (int i = 0; i < 32; ++i) { const int kk = 2 * i + (lane >> 5); vals[i] = src ? src[(size_t)(k0 + kk) * ld] : 0.f; }
    if (gain) {
#pragma unroll
        for (int i = 0; i < 32; ++i) { const int kk = 2 * i + (lane >> 5); vals[i] *= gain[k0 + kk]; }
    }
#pragma unroll
    for (int i = 0; i < 32; ++i) { const int kk = 2 * i + (lane >> 5); scr[kk * 33 + (lane & 31)] = vals[i]; }
    asm volatile("s_waitcnt lgkmcnt(0)" ::: "memory"); __builtin_amdgcn_wave_barrier();
    const int c = lane & 7;
#pragma unroll
    for (int j = 0; j < 4; ++j) { const int n = (lane >> 3) + 8 * j; const LAS float* s = scr + (8 * c) * 33 + n;
        u32x4 o; o.x = cvt_pk_bf16(s[0 * 33], s[1 * 33]); o.y = cvt_pk_bf16(s[2 * 33], s[3 * 33]); o.z = cvt_pk_bf16(s[4 * 33], s[5 * 33]); o.w = cvt_pk_bf16(s[6 * 33], s[7 * 33]);
        *(u32x4*)(WT + (size_t)(n0 + n) * K + k0 + 8 * c) = o; }
    asm volatile("s_waitcnt lgkmcnt(0)" ::: "memory"); __builtin_amdgcn_wave_barrier();
}
__device__ __forceinline__ float wave_sum(float v) {
#pragma unroll
    for (int o = 1; o < 64; o <<= 1) v += __shfl_xor(v, o);
    return v;
}
__device__ __forceinline__ void convert_weights(const Params& P, LAS unsigned char* lds, const int gw, const int NGW, const int mat_lo, const int mat_hi) {
    const int lane = threadIdx.x & 63, wave = threadIdx.x >> 6;
    LAS float* scr = (LAS float*)(lds + wave * 16384);
    unsigned char* ws = P.ws;
    constexpr int NV[10] = {5632, 1024, 3328, 4096, 2048, 1024, 1024, 1024, 5632, 1024};
    constexpr int KK[10] = {1024, 2816, 1024, 1024, 1024, 1024, 1024, 1024, 1024, 2816};
    const size_t WOFF[10] = {W_GU1, W_D1, W_QKV, W_SC, W_ZG, W_WA, W_WB, W_WO, W_GU2, W_D2};
    int base = 0;
#pragma unroll
    for (int mat = 0; mat < 10; ++mat) {
        if (mat < mat_lo || mat >= mat_hi) continue;
        const int nit = (KK[mat] / 64) * (NV[mat] / 32);
        const int first = (gw - (base % NGW) + NGW) % NGW;
        for (int it = first; it < nit; it += NGW) conv_item(P, mat, NV[mat], KK[mat], (bf16_t*)(ws + WOFF[mat]), it, scr, lane);
        base += nit;
    }
}
__device__ __forceinline__ void phase_prologue(const Params& P, LAS unsigned char* lds) {
    const int tid = threadIdx.x, lane = tid & 63, wave = tid >> 6;
    LAS float* scr = (LAS float*)(lds + wave * 16384);
    const int gw = blockIdx.x * 8 + wave, NGW = gridDim.x * 8;
    unsigned char* ws = P.ws;
    float* rs0 = (float*)(ws + OFF_RS0); bf16_t* xb = (bf16_t*)(ws + OFF_XB);
    for (int row0 = gw; row0 < TP; row0 += 2 * NGW) {
        const int row1 = row0 + NGW;
        const float* src0 = xin_row(P, row0); const float* src1 = row1 < TP ? xin_row(P, row1) : nullptr;
        f32x4 v0[4], v1[4];
#pragma unroll
        for (int j = 0; j < 4; ++j) { v0[j] = src0 ? ((const f32x4*)src0)[lane + 64 * j] : (f32x4){0.f, 0.f, 0.f, 0.f}; v1[j] = src1 ? ((const f32x4*)src1)[lane + 64 * j] : (f32x4){0.f, 0.f, 0.f, 0.f}; }
#pragma unroll
        for (int q = 0; q < 2; ++q) {
            const int row = q ? row1 : row0; const float* src = q ? src1 : src0;
            if (row >= TP) continue;
            float s = 0.f;
#pragma unroll
            for (int j = 0; j < 4; ++j) { const f32x4 v = q ? v1[j] : v0[j]; s += (v.x * v.x + v.y * v.y) + (v.z * v.z + v.w * v.w); }
            s = wave_sum(s);
            if (lane == 0) rs0[row] = src ? rsqrtf(s * (1.f / 1024.f) + EPS) : 0.f;
            u32x2* o8 = (u32x2*)(xb + (size_t)row * D) + lane;
#pragma unroll
            for (int j = 0; j < 4; ++j) { const f32x4 v = q ? v1[j] : v0[j]; u32x2 w; w.x = cvt_pk_bf16(v.x, v.y); w.y = cvt_pk_bf16(v.z, v.w); o8[64 * j] = w; }
        }
    }
    convert_weights(P, lds, gw, NGW, 0, gridDim.x >= 256 ? 3 : 10);
}

struct Item { int base_row, nreal, nv, h, kind  , seq, c; size_t ta_off; };
__device__ __forceinline__ Item item_decode(int item) {
    Item it;
    if (item < NITEM_P) { const int b = item / 264, c = (item >> 3) % 33; it.h = item & 7; it.seq = b; it.c = c;
        if (c == 0) { it.base_row = ROW_META + 16 * b; it.nreal = 16; it.kind = 1; } else { it.base_row = 2048 * b + 64 * (c - 1); it.nreal = 64; it.kind = 0; }
        it.nv = 64; it.ta_off = (size_t)item * 16384;
    } else { const int j = item - NITEM_P; it.seq = j >> 3; it.h = j & 7; it.c = 0; it.base_row = ROW_SAMPLE + 8 * it.seq; it.nreal = 8; it.kind = 2; it.nv = 16; it.ta_off = TA_SAMPLE + (size_t)j * 1024; }
    return it;
}
#define MFMA16(a, b, c) __builtin_amdgcn_mfma_f32_16x16x32_bf16((a), (b), (c), 0, 0, 0)
constexpr int KP = 136;
constexpr int TPI = 72;

typedef float f32x2 __attribute__((ext_vector_type(2)));
constexpr int PREP_WAVE_LDS = 17920;
__device__ __forceinline__ void lds_sync_wave() { asm volatile("s_waitcnt lgkmcnt(0)" ::: "memory"); __builtin_amdgcn_wave_barrier(); }
__device__ __forceinline__ void prep_stage_raw(const Params& P, const Item& it, const int wh, const int lane, LAS bf16_t* tile) {
    const int seg = lane & 7, c0 = it.h * 128 + seg * 16;
    const bf16_t* buf = (const bf16_t*)(P.ws + OFF_S0 + (size_t)wh * U1);
#pragma unroll 1
    for (int hb = 0; hb < 2; ++hb) {
        u32x4 a[4], b[4];
#pragma unroll
        for (int p = 0; p < 4; ++p) { const int r = 32 * hb + 8 * p + (lane >> 3);
            a[p] = (u32x4){0u, 0u, 0u, 0u}; b[p] = a[p];
            if (r < it.nreal) { const u32x4* q = (const u32x4*)(buf + (size_t)(it.base_row + r) * D + c0); a[p] = q[0]; b[p] = q[1]; } }
#pragma unroll
        for (int p = 0; p < 4; ++p) { const int r = 32 * hb + 8 * p + (lane >> 3); LAS u32x4* q = (LAS u32x4*)(tile + r * KP + seg * 16); q[0] = a[p]; q[1] = b[p]; }
    }
}
__device__ __forceinline__ void prep_pass(const Params& P, const Item& it, const int wh, const int p, const int lane, LAS bf16_t* tile, const bool dry, const f32x4 (&cw)[4][4]) {
    unsigned char* ws = P.ws;
    const int r = 8 * p + (lane >> 3), seg = lane & 7, c0 = it.h * 128 + seg * 16;
    bf16_t* buf = (bf16_t*)(ws + OFF_S0 + (size_t)wh * U1);
    float y[16];
#pragma unroll
    for (int e = 0; e < 16; ++e) y[e] = 0.f;
#pragma unroll
    for (int d = 0; d < 4; ++d) {
        const int rr = r - 3 + d;
        u32x4 a = (u32x4){0u, 0u, 0u, 0u}, b = a;
        if (r < it.nreal) {
            if (rr >= 0) { const LAS u32x4* q = (const LAS u32x4*)(tile + rr * KP + seg * 16); a = q[0]; b = q[1]; }
            else if (it.kind == 0) { const u32x4* q = (const u32x4*)((const bf16_t*)(ws + OFF_HALO) + (size_t)((it.seq * 33 + it.c) * 3 + (rr + 3)) * 3072 + wh * 1024 + c0); a = q[0]; b = q[1]; }
            else if (it.kind == 2) { const f32x4* q = (const f32x4*)(P.in[3] + (size_t)(it.seq * 3 + (rr + 3)) * 3072 + wh * 1024 + c0);
                { const f32x4 f0 = q[0], f1 = q[1]; a.x = cvt_pk_bf16(f0.x, f0.y); a.y = cvt_pk_bf16(f0.z, f0.w); a.z = cvt_pk_bf16(f1.x, f1.y); a.w = cvt_pk_bf16(f1.z, f1.w); }
                { const f32x4 f2 = q[2], f3 = q[3]; b.x = cvt_pk_bf16(f2.x, f2.y); b.y = cvt_pk_bf16(f2.z, f2.w); b.z = cvt_pk_bf16(f3.x, f3.y); b.w = cvt_pk_bf16(f3.z, f3.w); } }
        }
        { const f32x4 w0 = cw[d][0], w1 = cw[d][1];
          y[0] += w0.x * bf_lo(a.x); y[1] += w0.y * bf_hi(a.x); y[2] += w0.z * bf_lo(a.y); y[3] += w0.w * bf_hi(a.y);
          y[4] += w1.x * bf_lo(a.z); y[5] += w1.y * bf_hi(a.z); y[6] += w1.z * bf_lo(a.w); y[7] += w1.w * bf_hi(a.w); }
        { const f32x4 w2 = cw[d][2], w3 = cw[d][3];
          y[8] += w2.x * bf_lo(b.x); y[9] += w2.y * bf_hi(b.x); y[10] += w2.z * bf_lo(b.y); y[11] += w2.w * bf_hi(b.y);
          y[12] += w3.x * bf_lo(b.z); y[13] += w3.y * bf_hi(b.z); y[14] += w3.z * bf_lo(b.w); y[15] += w3.w * bf_hi(b.w); }
    }
    float ss = 0.f;
#pragma unroll
    for (int e = 0; e < 16; ++e) { y[e] = siluf(y[e]); ss += y[e] * y[e]; }
    float sc = 1.f;
    if (wh < 2) { ss += __shfl_xor(ss, 1); ss += __shfl_xor(ss, 2); ss += __shfl_xor(ss, 4);
        sc = rsqrtf(ss + 1e-6f) * (wh == 0 ? 0.08838834764831845f : 1.f); }
    u32x4 o0, o1;
    o0.x = cvt_pk_bf16(y[0] * sc, y[1] * sc); o0.y = cvt_pk_bf16(y[2] * sc, y[3] * sc); o0.z = cvt_pk_bf16(y[4] * sc, y[5] * sc); o0.w = cvt_pk_bf16(y[6] * sc, y[7] * sc);
    o1.x = cvt_pk_bf16(y[8] * sc, y[9] * sc); o1.y = cvt_pk_bf16(y[10] * sc, y[11] * sc); o1.z = cvt_pk_bf16(y[12] * sc, y[13] * sc); o1.w = cvt_pk_bf16(y[14] * sc, y[15] * sc);
    if (r >= it.nreal) { o0 = (u32x4){0u, 0u, 0u, 0u}; o1 = o0; }
    else if (!dry) { u32x4* q = (u32x4*)(buf + (size_t)(it.base_row + r) * D + c0); q[0] = o0; q[1] = o1; }
    asm volatile("s_waitcnt lgkmcnt(0)" ::: "memory");
    { LAS u32x4* q = (LAS u32x4*)(tile + r * KP + seg * 16); q[0] = o0; q[1] = o1; }
}
template <int NR>
__device__ __forceinline__ void prep_solve(const LAS float* Akk, bf16_t* tm, const int nv, const int lane, const bool dry) {
    f32x2 xa[NR / 2];
#pragma unroll
    for (int i = 0; i < NR / 2; ++i) xa[i] = (f32x2){0.f, 0.f};
#pragma unroll
    for (int i = 0; i < NR; ++i) {
        f32x2 s0 = (f32x2){0.f, 0.f}, s1 = s0;
#pragma unroll
        for (int j4 = 0; j4 < (i + 3) / 4; ++j4) {
            const f32x4 a = *(const LAS f32x4*)(Akk + i * 68 + 4 * j4);
            s0 += (f32x2){a.x, a.y} * xa[2 * j4]; s1 += (f32x2){a.z, a.w} * xa[2 * j4 + 1];
        }
        const float xi = ((lane == i) ? 1.f : 0.f) - ((s0.x + s0.y) + (s1.x + s1.y));
        if (i & 1) xa[i >> 1].y = xi; else xa[i >> 1].x = xi;
        if (lane < nv && !dry) tm[i * nv + lane] = f2bf(xi);
    }
}
__device__ __forceinline__ void prep_item(const Params& P, const int item, LAS unsigned char* wl, const int lane_in, const bool dry, const bool dryq) {
    int lane = lane_in; asm volatile("" : "+v"(lane));
    unsigned char* ws = P.ws;
    const Item it = item_decode(item);
    const int fr = lane & 15, fq = lane >> 4;
    LAS bf16_t* tile = (LAS bf16_t*)wl; LAS float* Akk = (LAS float*)wl; LAS float* gl = (LAS float*)(wl + 17408); LAS float* bl = gl + 64;
    const bool light = it.nreal < 64;
    const int npass = (it.nreal + 7) >> 3;
    bf16_t* tm = (bf16_t*)(ws + OFF_S3 + it.ta_off); bf16_t* aqk = tm + it.nv * it.nv;
    {
        float la = 0.f, be = 0.f;
        if (lane < it.nreal) { const float* ab = (const float*)(ws + OFF_AB) + (size_t)(it.base_row + lane) * 16;
            const float ar = ab[it.h] + P.in[15][it.h], br = ab[8 + it.h];
            const float sp = ar > 20.f ? ar : log1pf(expf(ar));
            la = -expf(P.in[14][it.h]) * sp; be = 1.f / (1.f + expf(-br)); }
#pragma unroll
        for (int o = 1; o < 64; o <<= 1) { const float t = __shfl_up(la, o); if (lane >= o) la += t; }
        gl[lane] = la; bl[lane] = be;
        if (!dry) { float* gb = (float*)(ws + OFF_GB) + (size_t)item * 128; gb[lane] = la; gb[64 + lane] = be; }
    }
    bf16x8 Qf[4][4];
#pragma unroll
    for (int t = 0; t < 4; ++t)
#pragma unroll
        for (int ks = 0; ks < 4; ++ks) Qf[t][ks] = (bf16x8){0, 0, 0, 0, 0, 0, 0, 0};
#pragma unroll 1
    for (int stage = 0; stage < 3; ++stage) {
        const int wh = stage == 0 ? 2 : stage - 1;
        lds_sync_wave();
        prep_stage_raw(P, it, wh, lane, tile);
        lds_sync_wave();
        f32x4 cw[4][4];
        { const float* convw = P.in[13] + wh * 1024 + it.h * 128 + (lane & 7) * 16;
#pragma unroll
          for (int d = 0; d < 4; ++d)
#pragma unroll
              for (int e = 0; e < 4; ++e) cw[d][e] = *(const f32x4*)(convw + (size_t)d * 3072 + 4 * e); }
#pragma unroll 1
        for (int p = npass - 1; p >= 0; --p) prep_pass(P, it, wh, p, lane, tile, dryq, cw);
        if (wh == 0) {
            lds_sync_wave();
#pragma unroll
            for (int t = 0; t < 4; ++t)
#pragma unroll
                for (int ks = 0; ks < 4; ++ks) Qf[t][ks] = *(const LAS bf16x8*)(tile + (16 * t + fr) * KP + 32 * ks + 8 * fq);
        }
    }
    lds_sync_wave();
#pragma unroll
    for (int mi = 0; mi < 4; ++mi) {
        const int i = 16 * mi + fr; const float gi = gl[i];
#pragma unroll
        for (int nj = 0; nj < 4; ++nj) {
            f32x4 d = (f32x4){0.f, 0.f, 0.f, 0.f};
            if (nj <= mi) {
#pragma unroll
                for (int ks = 0; ks < 4; ++ks) { const bf16x8 a = *(const LAS bf16x8*)(tile + (16 * nj + fr) * KP + 32 * ks + 8 * fq); d = MFMA16(a, Qf[mi][ks], d); }
            }
            const int j0 = 16 * nj + 4 * fq;
            f32x4 o;
#pragma unroll
            for (int rr = 0; rr < 4; ++rr) { const int j = j0 + rr; o[rr] = (nj <= mi && i >= j) ? d[rr] * __expf(gi - gl[j]) : 0.f; }
            if (i < it.nv && j0 < it.nv && !dry) { u32x2 w; w.x = cvt_pk_bf16(o[0], o[1]); w.y = cvt_pk_bf16(o[2], o[3]); *(u32x2*)(aqk + i * it.nv + j0) = w; }
        }
    }
    f32x4 kk[10];
#pragma unroll
    for (int mi = 0; mi < 4; ++mi) {
        bf16x8 Kb[4];
#pragma unroll
        for (int ks = 0; ks < 4; ++ks) Kb[ks] = *(const LAS bf16x8*)(tile + (16 * mi + fr) * KP + 32 * ks + 8 * fq);
#pragma unroll
        for (int nj = 0; nj <= mi; ++nj) {
            f32x4 d = (f32x4){0.f, 0.f, 0.f, 0.f};
#pragma unroll
            for (int ks = 0; ks < 4; ++ks) { const bf16x8 a = *(const LAS bf16x8*)(tile + (16 * nj + fr) * KP + 32 * ks + 8 * fq); d = MFMA16(a, Kb[ks], d); }
            kk[mi * (mi + 1) / 2 + nj] = d;
        }
    }
    lds_sync_wave();
#pragma unroll
    for (int mi = 0; mi < 4; ++mi) {
        const int i = 16 * mi + fr; const float gi = gl[i], bi = bl[i];
#pragma unroll
        for (int nj = 0; nj < 4; ++nj) {
            const int j0 = 16 * nj + 4 * fq;
            f32x4 o = (f32x4){0.f, 0.f, 0.f, 0.f};
            if (nj <= mi) {
                const f32x4 d = kk[mi * (mi + 1) / 2 + nj];
#pragma unroll
                for (int rr = 0; rr < 4; ++rr) { const int j = j0 + rr; o[rr] = (i > j) ? d[rr] * bi * __expf(gi - gl[j]) : 0.f; }
            }
            *(LAS f32x4*)(Akk + i * 68 + j0) = o;
        }
    }
    lds_sync_wave();
    if (!light) prep_solve<64>(Akk, tm, 64, lane, dry);
    else {
        prep_solve<16>(Akk, tm, it.nv, lane, dry);
        if (it.nv == 64 && !dry) for (int i = 16; i < 64; ++i) tm[i * 64 + lane] = (lane == i) ? (bf16_t)0x3F80u : (bf16_t)0u;
    }
    lds_sync_wave();
}
__device__ __forceinline__ void phase_prep(const Params& P, LAS unsigned char* lds, const bool dry = false, const bool dryq = false) {
    const int lane = threadIdx.x & 63, wave = __builtin_amdgcn_readfirstlane(threadIdx.x >> 6);
    LAS unsigned char* wl = lds + wave * PREP_WAVE_LDS;
    const int gw = blockIdx.x * 8 + wave, NGW = gridDim.x * 8;
#pragma unroll 1
    for (int sl = gw; sl < 2048; sl += NGW) {
        const int b = sl >> 8, c = 1 + ((sl >> 3) & 31), h = sl & 7;
        prep_item(P, (b * 33 + c) * 8 + h, wl, lane, dry, dryq);
    }
#pragma unroll 1
    for (int lt = wave * (int)gridDim.x + (int)blockIdx.x; lt < 64 + NITEM_S; lt += NGW) {
        const int item = lt < 64 ? ((lt >> 3) * 33) * 8 + (lt & 7) : NITEM_P + (lt - 64);
        prep_item(P, item, wl, lane, dry, dryq);
    }
}

__device__ __forceinline__ bf16x8 ldfrag_g(const bf16_t* base, int ld, int nvalid, int row, int col) {
    bf16x8 z = (bf16x8){0, 0, 0, 0, 0, 0, 0, 0};
    if (row < nvalid && col < ld) z = *(const bf16x8*)(base + (size_t)row * ld + col);
    return z;
}
#define REC_BAR() do { asm volatile("s_waitcnt lgkmcnt(0)" ::: "memory"); __builtin_amdgcn_s_barrier(); asm volatile("" ::: "memory"); } while (0)
template <int DVW>
__device__ __forceinline__ void rec_unit(const Params& P, LAS unsigned char* lds, const int item0, const int nchunks, const int h, const int dvs, const float* s0, float* sfin, const bool dry) {
    constexpr int TT = DVW / 32, ST = DVW / 16, HW = DVW / 2;
    const int tid = threadIdx.x, lane = tid & 63, wid = __builtin_amdgcn_readfirstlane(tid >> 6), fr = lane & 15, fq = lane >> 4;
    const int mi = wid & 3, nh = wid >> 2;
    unsigned char* ws = P.ws;
    LAS bf16_t* Sb = (LAS bf16_t*)lds;
    LAS bf16_t* Kl0 = (LAS bf16_t*)(lds + 34816);
    LAS bf16_t* Xt = (LAS bf16_t*)(lds + 52224);
    LAS bf16_t* NUt = (LAS bf16_t*)(lds + 70656);
    LAS bf16_t* NDt = (LAS bf16_t*)(lds + 89088);
    LAS float* gl0 = (LAS float*)(lds + 107520);
    const bf16_t* qbuf = (const bf16_t*)(ws + OFF_S0); const bf16_t* kbuf = (const bf16_t*)(ws + OFF_S1); bf16_t* vbuf = (bf16_t*)(ws + OFF_S2);
    float* ssqb = (float*)(ws + OFF_SSQ);
    const int i = 16 * mi + fr;
    f32x4 S[ST];
#pragma unroll
    for (int t = 0; t < ST; ++t) {
        if (s0) {
#pragma unroll
            for (int r = 0; r < 4; ++r) S[t][r] = s0[(size_t)(16 * wid + 4 * fq + r) * 128 + dvs + 16 * t + fr];
        } else S[t] = (f32x4){0.f, 0.f, 0.f, 0.f};
        u32x2 w; w.x = cvt_pk_bf16(S[t][0], S[t][1]); w.y = cvt_pk_bf16(S[t][2], S[t][3]);
        *(LAS u32x2*)(Sb + (16 * t + fr) * KP + 16 * wid + 4 * fq) = w;
    }
    bf16x8 pq[4], ptm[2], paq[2]; u32x2 pv[TT]; u32x4 pka, pkb; float pgb;
#define REC_PREFETCH(ITEM) do { const Item nx = item_decode(ITEM); \
        const bf16_t* tmn = (const bf16_t*)(ws + OFF_S3 + nx.ta_off); const bf16_t* aqn = tmn + nx.nv * nx.nv; \
        _Pragma("unroll") for (int ks = 0; ks < 4; ++ks) { pq[ks] = (bf16x8){0, 0, 0, 0, 0, 0, 0, 0}; \
            if (i < nx.nreal) pq[ks] = *(const bf16x8*)(qbuf + (size_t)(nx.base_row + i) * D + h * 128 + 32 * ks + 8 * fq); } \
        _Pragma("unroll") for (int t = 0; t < TT; ++t) { pv[t] = (u32x2){0u, 0u}; \
            if (i < nx.nreal) pv[t] = *(const u32x2*)(vbuf + (size_t)(nx.base_row + i) * D + h * 128 + dvs + HW * nh + 16 * t + 4 * fq); } \
        _Pragma("unroll") for (int ks = 0; ks < 2; ++ks) { ptm[ks] = ldfrag_g(tmn, nx.nv, nx.nv, i, 32 * ks + 8 * fq); paq[ks] = ldfrag_g(aqn, nx.nv, nx.nv, i, 32 * ks + 8 * fq); } \
        { const int r_ = tid >> 3, seg_ = tid & 7; pka = (u32x4){0u, 0u, 0u, 0u}; pkb = pka; \
          if (r_ < nx.nreal) { const u32x4* p_ = (const u32x4*)(kbuf + (size_t)(nx.base_row + r_) * D + h * 128 + seg_ * 16); pka = p_[0]; pkb = p_[1]; } } \
        pgb = (tid < 128) ? ((const float*)(ws + OFF_GB))[(size_t)(ITEM) * 128 + tid] : 0.f; } while (0)
    REC_PREFETCH(item0);
#pragma unroll 1
    for (int c = 0; c < nchunks; ++c) {
        const int item = item0 + c * 8;
        const Item it = item_decode(item);
        LAS bf16_t* Kl = (LAS bf16_t*)((LAS unsigned char*)Kl0 + (c & 1) * 73728);
        LAS float* gl = (LAS float*)((LAS unsigned char*)gl0 + (c & 1) * 18432); LAS float* bl = gl + 64;
        bf16x8 cq[4], ctm[2], caq[2]; u32x2 cv[TT];
#pragma unroll
        for (int ks = 0; ks < 4; ++ks) cq[ks] = pq[ks];
#pragma unroll
        for (int t = 0; t < TT; ++t) cv[t] = pv[t];
#pragma unroll
        for (int ks = 0; ks < 2; ++ks) { ctm[ks] = ptm[ks]; caq[ks] = paq[ks]; }
        { const int r = tid >> 3, seg = tid & 7; LAS u32x4* q = (LAS u32x4*)(Kl + r * KP + seg * 16); q[0] = pka; q[1] = pkb;
          if (tid < 128) gl[tid] = pgb; }
        __syncthreads();
        if (c + 1 < nchunks) REC_PREFETCH(item + 8);
        const float gi = gl[i], bi = bl[i], glast = gl[63];
        const float egi = __expf(gi), edi = __expf(glast - gi), egl = __expf(glast);
        f32x4 Pt[TT], Qt[TT];
#pragma unroll
        for (int t = 0; t < TT; ++t) { Pt[t] = (f32x4){0.f, 0.f, 0.f, 0.f}; Qt[t] = Pt[t]; }
#pragma unroll
        for (int ks = 0; ks < 4; ++ks) {
            const bf16x8 bk = *(const LAS bf16x8*)(Kl + i * KP + 32 * ks + 8 * fq);
#pragma unroll
            for (int t = 0; t < TT; ++t) {
                const bf16x8 a = *(const LAS bf16x8*)(Sb + (HW * nh + 16 * t + fr) * KP + 32 * ks + 8 * fq);
                Pt[t] = MFMA16(a, bk, Pt[t]); Qt[t] = MFMA16(a, cq[ks], Qt[t]);
            }
        }
#pragma unroll
        for (int t = 0; t < TT; ++t) {
            const int dv0 = HW * nh + 16 * t + 4 * fq;
            const u32x2 vv = cv[t];
            const float x0 = bi * (bf_lo(vv.x) - egi * Pt[t][0]), x1 = bi * (bf_hi(vv.x) - egi * Pt[t][1]), x2 = bi * (bf_lo(vv.y) - egi * Pt[t][2]), x3 = bi * (bf_hi(vv.y) - egi * Pt[t][3]);
            Xt[(dv0 + 0) * TPI + i] = f2bf(x0); Xt[(dv0 + 1) * TPI + i] = f2bf(x1); Xt[(dv0 + 2) * TPI + i] = f2bf(x2); Xt[(dv0 + 3) * TPI + i] = f2bf(x3);
        }
        REC_BAR();
        f32x4 Nu[TT];
#pragma unroll
        for (int t = 0; t < TT; ++t) Nu[t] = (f32x4){0.f, 0.f, 0.f, 0.f};
#pragma unroll
        for (int ks = 0; ks < 2; ++ks) {
#pragma unroll
            for (int t = 0; t < TT; ++t) {
                const bf16x8 a = *(const LAS bf16x8*)(Xt + (HW * nh + 16 * t + fr) * TPI + 32 * ks + 8 * fq);
                Nu[t] = MFMA16(a, ctm[ks], Nu[t]);
            }
        }
#pragma unroll
        for (int t = 0; t < TT; ++t) {
            const int dv0 = HW * nh + 16 * t + 4 * fq;
#pragma unroll
            for (int r = 0; r < 4; ++r) { NUt[(dv0 + r) * TPI + i] = f2bf(Nu[t][r]); NDt[(dv0 + r) * TPI + i] = f2bf(Nu[t][r] * edi); }
        }
        REC_BAR();
#pragma unroll
        for (int t = 0; t < TT; ++t) Qt[t] = Qt[t] * egi;
#pragma unroll
        for (int ks = 0; ks < 2; ++ks) {
#pragma unroll
            for (int t = 0; t < TT; ++t) {
                const bf16x8 a = *(const LAS bf16x8*)(NUt + (HW * nh + 16 * t + fr) * TPI + 32 * ks + 8 * fq);
                Qt[t] = MFMA16(a, caq[ks], Qt[t]);
            }
        }
#pragma unroll
        for (int t = 0; t < TT; ++t) {
            const int dvl = HW * nh + 16 * t;
            float sq = (Qt[t][0] * Qt[t][0] + Qt[t][1] * Qt[t][1]) + (Qt[t][2] * Qt[t][2] + Qt[t][3] * Qt[t][3]);
            sq += __shfl_xor(sq, 16); sq += __shfl_xor(sq, 32);
            if (i < it.nreal && !dry) {
                if (fq == 0) ssqb[(size_t)(it.base_row + i) * 64 + h * 8 + ((dvs + dvl) >> 4)] = sq;
                u32x2 w; w.x = cvt_pk_bf16(Qt[t][0], Qt[t][1]); w.y = cvt_pk_bf16(Qt[t][2], Qt[t][3]);
                *(u32x2*)(vbuf + (size_t)(it.base_row + i) * D + h * 128 + dvs + dvl + 4 * fq) = w;
            }
        }
#pragma unroll
        for (int t = 0; t < ST; ++t) S[t] = S[t] * egl;
#pragma unroll
        for (int ks = 0; ks < 2; ++ks) {
            bf16x8 a;
#pragma unroll
            for (int e = 0; e < 8; ++e) a[e] = (short)Kl[(32 * ks + 8 * fq + e) * KP + 16 * wid + fr];
#pragma unroll
            for (int t = 0; t < ST; ++t) {
                const bf16x8 b = *(const LAS bf16x8*)(NDt + (16 * t + fr) * TPI + 32 * ks + 8 * fq);
                S[t] = MFMA16(a, b, S[t]);
            }
        }
#pragma unroll
        for (int t = 0; t < ST; ++t) { u32x2 w; w.x = cvt_pk_bf16(S[t][0], S[t][1]); w.y = cvt_pk_bf16(S[t][2], S[t][3]);
            *(LAS u32x2*)(Sb + (16 * t + fr) * KP + 16 * wid + 4 * fq) = w; }
    }
#pragma unroll
    for (int t = 0; t < ST; ++t)
#pragma unroll
        for (int r = 0; r < 4; ++r) if (!dry) sfin[(size_t)(16 * wid + 4 * fq + r) * 128 + dvs + 16 * t + fr] = S[t][r];
    __syncthreads();
}
__device__ __forceinline__ void phase_rec(const Params& P, LAS unsigned char* lds, const bool dry = false) {
    const int G = gridDim.x, bx = blockIdx.x;
    if (G >= 256) {
        if (bx < 128) { const int chain = bx & 63, sl = bx >> 6, b = chain >> 3, h = chain & 7;
            rec_unit<64>(P, lds, b * 264 + h, 33, h, 64 * sl, nullptr, P.out + O_PGS + (size_t)chain * 16384, dry); }
        else {
#pragma unroll 1
            for (int j = bx - 128; j < 1024; j += G - 128)
                rec_unit<128>(P, lds, NITEM_P + j, 1, j & 7, 0, P.in[4] + (size_t)j * 16384, P.out + O_SGS + (size_t)j * 16384, dry);
            __syncthreads();
            convert_weights(P, lds, (bx - 128) * 8 + (int)(threadIdx.x >> 6), (G - 128) * 8, 3, 10);
        }
    } else {
#pragma unroll 1
        for (int pu = bx; pu < 128; pu += G) { const int chain = pu & 63, sl = pu >> 6, b = chain >> 3, h = chain & 7;
            rec_unit<64>(P, lds, b * 264 + h, 33, h, 64 * sl, nullptr, P.out + O_PGS + (size_t)chain * 16384, dry); }
#pragma unroll 1
        for (int j = bx; j < 1024; j += G)
            rec_unit<128>(P, lds, NITEM_P + j, 1, j & 7, 0, P.in[4] + (size_t)j * 16384, P.out + O_SGS + (size_t)j * 16384, dry);
    }
}

__device__ __forceinline__ void phase_ya(const Params& P) {
    unsigned char* ws = P.ws;
    const bf16_t* pbuf = (const bf16_t*)(ws + OFF_S0); bf16_t* scb = (bf16_t*)(ws + OFF_S1);
    const float* w = P.in[12];
    const long total = (long)TREAL * 128;
    for (long idx = (long)blockIdx.x * 512 + threadIdx.x; idx < total; idx += (long)gridDim.x * 512) {
        const int row = (int)(idx >> 7), c0 = (int)(idx & 127) * 8;
        int r1 = -1, r2 = -1; const float* f1 = nullptr; const float* f2 = nullptr;
        if (row < ROW_SAMPLE) { const int b = row >> 11, s = row & 2047;
            r1 = s >= 1 ? row - 1 : ROW_META + 16 * b + 15; r2 = s >= 2 ? row - 2 : ROW_META + 16 * b + 14 + s; }
        else if (row < ROW_META) { const int i = (row - ROW_SAMPLE) >> 3, t = row & 7;
            if (t >= 1) r1 = row - 1; else f1 = P.in[2] + (size_t)(i * 2 + 1) * 1024;
            if (t >= 2) r2 = row - 2; else f2 = P.in[2] + (size_t)(i * 2 + t) * 1024; }
        else { const int mm = row & 15; if (mm >= 1) r1 = row - 1; if (mm >= 2) r2 = row - 2; }
        float x0[8], x1[8], x2[8];
        { const u32x4 a = *(const u32x4*)(pbuf + (size_t)row * D + c0); x2[0] = bf_lo(a.x); x2[1] = bf_hi(a.x); x2[2] = bf_lo(a.y); x2[3] = bf_hi(a.y); x2[4] = bf_lo(a.z); x2[5] = bf_hi(a.z); x2[6] = bf_lo(a.w); x2[7] = bf_hi(a.w); }
        if (r1 >= 0) { const u32x4 a = *(const u32x4*)(pbuf + (size_t)r1 * D + c0); x1[0] = bf_lo(a.x); x1[1] = bf_hi(a.x); x1[2] = bf_lo(a.y); x1[3] = bf_hi(a.y); x1[4] = bf_lo(a.z); x1[5] = bf_hi(a.z); x1[6] = bf_lo(a.w); x1[7] = bf_hi(a.w); }
        else if (f1) { const f32x4 a = *(const f32x4*)(f1 + c0), b = *(const f32x4*)(f1 + c0 + 4); x1[0] = a.x; x1[1] = a.y; x1[2] = a.z; x1[3] = a.w; x1[4] = b.x; x1[5] = b.y; x1[6] = b.z; x1[7] = b.w; }
        else {
#pragma unroll
            for (int e = 0; e < 8; ++e) x1[e] = 0.f; }
        if (r2 >= 0) { const u32x4 a = *(const u32x4*)(pbuf + (size_t)r2 * D + c0); x0[0] = bf_lo(a.x); x0[1] = bf_hi(a.x); x0[2] = bf_lo(a.y); x0[3] = bf_hi(a.y); x0[4] = bf_lo(a.z); x0[5] = bf_hi(a.z); x0[6] = bf_lo(a.w); x0[7] = bf_hi(a.w); }
        else if (f2) { const f32x4 a = *(const f32x4*)(f2 + c0), b = *(const f32x4*)(f2 + c0 + 4); x0[0] = a.x; x0[1] = a.y; x0[2] = a.z; x0[3] = a.w; x0[4] = b.x; x0[5] = b.y; x0[6] = b.z; x0[7] = b.w; }
        else {
#pragma unroll
            for (int e = 0; e < 8; ++e) x0[e] = 0.f; }
        const u32x4 sb = *(const u32x4*)(scb + (size_t)row * D + c0);
        const float sbf[8] = {bf_lo(sb.x), bf_hi(sb.x), bf_lo(sb.y), bf_hi(sb.y), bf_lo(sb.z), bf_hi(sb.z), bf_lo(sb.w), bf_hi(sb.w)};
        float y[8];
#pragma unroll
        for (int e = 0; e < 8; ++e) y[e] = sbf[e] * (w[c0 + e] * x0[e] + w[1024 + c0 + e] * x1[e] + w[2048 + c0 + e] * x2[e]);
        u32x4 o; o.x = cvt_pk_bf16(y[0], y[1]); o.y = cvt_pk_bf16(y[2], y[3]); o.z = cvt_pk_bf16(y[4], y[5]); o.w = cvt_pk_bf16(y[6], y[7]);
        *(u32x4*)(scb + (size_t)row * D + c0) = o;
    }
}

__device__ __forceinline__ void phase_final(const Params& P, const int row_lo) {
    const int lane = threadIdx.x & 63, wave = threadIdx.x >> 6;
    const float* part = (const float*)(P.ws + OFF_P3); const float* gf = P.in[24];
    for (int row = row_lo + blockIdx.x * 8 + wave; row < ROW_META; row += gridDim.x * 8) {
        const float rs = rs_from_part(part, row);
        f32x4* x = (f32x4*)(P.out + (size_t)row * D);
#pragma unroll
        for (int j = 0; j < 4; ++j) { f32x4 v = x[lane + 64 * j]; const f32x4 g = ((const f32x4*)gf)[lane + 64 * j]; v = v * rs * g; x[lane + 64 * j] = v; }
    }
}


#define XB_TMO      128
#define XB_XCNT(j)  (256  + 64 * (j))
#define XB_XSUB(j)  (1280 + 64 * (j))
#define XB_XGEN(j)  (2304 + 64 * (j))
#define XB_TOP      3328
#define XB_TOPGEN   3392
#define XCD_BAR_WORDS 3456
#define XB_SPIN_CAP (1u << 22)
__device__ __forceinline__ unsigned xb_ld(unsigned* p)              { return __hip_atomic_load(p, __ATOMIC_RELAXED, __HIP_MEMORY_SCOPE_AGENT); }
__device__ __forceinline__ unsigned xb_add(unsigned* p, unsigned v) { return __hip_atomic_fetch_add(p, v, __ATOMIC_RELAXED, __HIP_MEMORY_SCOPE_AGENT); }
__device__ __forceinline__ unsigned xb_xcc_id() { return (unsigned)__builtin_amdgcn_s_getreg((3 << 11) | 20) & 0xFu; }
#define XB_SPIN(cond, bar) do { unsigned _sp = 0; while (cond) { __builtin_amdgcn_s_sleep(1); \
    if ((++_sp & 255u) == 0u) { if (xb_ld(&(bar)[XB_TMO])) break; if (_sp > XB_SPIN_CAP) { atomicAdd(&(bar)[XB_TMO], 1u); break; } } } } while (0)
struct XcdBarrier { unsigned* bar; unsigned x; volatile LAS unsigned* st; };
__device__ __forceinline__ XcdBarrier xcd_barrier_post(unsigned* bar, volatile LAS unsigned* st) {
    XcdBarrier b; b.bar = bar; b.x = xb_xcc_id(); b.st = st;
    if (threadIdx.x == 0) (void)xb_add(&bar[XB_XCNT(b.x)], 1u);
    return b;
}
__device__ __forceinline__ void xcd_barrier_complete(unsigned* bar, unsigned x, unsigned& nloc, unsigned& nx) {
    const unsigned G = gridDim.x * gridDim.y * gridDim.z;
    unsigned sum, cnt, mine, sp = 0u;
    for (;;) {
        sum = 0u; cnt = 0u; mine = 0u;
#pragma unroll
        for (unsigned j = 0; j < 16; ++j) { const unsigned c = xb_ld(&bar[XB_XCNT(j)]); sum += c; cnt += (c > 0u) ? 1u : 0u; mine = (j == x) ? c : mine; }
        if (sum == G) break;
        __builtin_amdgcn_s_sleep(1);
        if ((++sp & 255u) == 0u) { if (xb_ld(&bar[XB_TMO])) break; if (sp > XB_SPIN_CAP) { atomicAdd(&bar[XB_TMO], 1u); break; } }
    }
    nloc = mine > 0u ? mine : 1u; nx = cnt > 0u ? cnt : 1u;
}
__device__ __forceinline__ void xcd_barrier(const XcdBarrier& b) {
    asm volatile("s_waitcnt vmcnt(0)" ::: "memory");
    __syncthreads();
    if (threadIdx.x == 0) {
        unsigned* bar = b.bar;
        __builtin_amdgcn_s_waitcnt(0);
        unsigned nloc = b.st[0], nx = b.st[1];
        if (nloc == 0u) { xcd_barrier_complete(bar, b.x, nloc, nx); b.st[0] = nloc; b.st[1] = nx; }
        const unsigned old = xb_add(&bar[XB_XSUB(b.x)], 1u);
        const unsigned gen = old / nloc;
        if (old + 1u == (gen + 1u) * nloc) {
            __builtin_amdgcn_fence(__ATOMIC_RELEASE, "agent");
            asm volatile("s_waitcnt vmcnt(0)" ::: "memory");
            const unsigned og = xb_add(&bar[XB_TOP], 1u);
            const unsigned tg = og / nx;
            if (og + 1u == (tg + 1u) * nx) xb_add(&bar[XB_TOPGEN], 1u);
            else XB_SPIN(xb_ld(&bar[XB_TOPGEN]) == tg, bar);
            __builtin_amdgcn_fence(__ATOMIC_ACQUIRE, "agent");
            xb_add(&bar[XB_XGEN(b.x)], 1u);
            asm volatile("s_waitcnt vmcnt(0)" ::: "memory");
        } else {
            XB_SPIN(xb_ld(&bar[XB_XGEN(b.x)]) == gen, bar);
            __builtin_amdgcn_fence(__ATOMIC_ACQUIRE, "agent");
            asm volatile("s_waitcnt vmcnt(0)" ::: "memory");
        }
    }
    __syncthreads();
}

constexpr int NPHASE = 15;
constexpr int LDS_BYTES = 147456;
__global__ void __launch_bounds__(512, 2) mega(Params P) {
    extern __shared__ __attribute__((aligned(16))) unsigned char lds_raw[];
    LAS unsigned char* lds = (LAS unsigned char*)lds_raw;
    unsigned char* ws = P.ws;
    const int G = gridDim.x, cid = blockIdx.x;
    volatile LAS unsigned* bst = (volatile LAS unsigned*)(lds + 147392);
    XcdBarrier xbar; xbar.bar = (unsigned*)(ws + OFF_CTL); xbar.x = 0; xbar.st = bst;
    if (P.ph_hi - P.ph_lo > 1) {
        if (threadIdx.x < 2) bst[threadIdx.x] = 0u;
        __syncthreads();
        xbar = xcd_barrier_post((unsigned*)(ws + OFF_CTL), bst);
        cg::this_grid().sync();
    }
    bf16_t* xb = (bf16_t*)(ws + OFF_XB);
    bf16_t* S0 = (bf16_t*)(ws + OFF_S0); bf16_t* S1 = (bf16_t*)(ws + OFF_S1); bf16_t* S2 = (bf16_t*)(ws + OFF_S2); bf16_t* S3 = (bf16_t*)(ws + OFF_S3);
    float* P1 = (float*)(ws + OFF_P1); float* P2 = (float*)(ws + OFF_P2); float* P3 = (float*)(ws + OFF_P3);
#define IN(k) (P.ph_lo <= (k) && (k) < P.ph_hi)
#define SEAM(k) do { if (IN(k) && IN((k) + 1)) { xcd_barrier(xbar); } } while (0)
#define GEMM1K(EpiT, E, Aptr, lda_, Bptr, K_) do { pg8::Gemm g{(const bf16_t*)(Aptr), (const bf16_t*)(Bptr), ROW_SAMPLE, D, (K_), (lda_), (K_)}; \
        pg8::StaticOrder S; S.init(ROW_SAMPLE, D, G, cid); pg8::gemm_phase<EpiT>(lds, g, S, E); } while (0)
#define GEMM(EpiT, E, Aptr, lda_, Bptr, N_, K_) do { pg8::Gemm g{(const bf16_t*)(Aptr), (const bf16_t*)(Bptr), TP, (N_), (K_), (lda_), (K_)}; \
        pg8::StaticOrder S; S.init(TP, (N_), G, cid); pg8::gemm_phase<EpiT>(lds, g, S, E); } while (0)

    if ((PROBE & 16) && IN(0)) { phase_prologue(P, lds); xcd_barrier(xbar); }
    if (IN(0)) { phase_prologue(P, lds); } SEAM(0);
    if (IN(1)) { EpiUp E{(const float*)(ws + OFF_RS0), nullptr, S0}; GEMM(EpiUp, E, xb, D, ws + W_GU1, 2 * FF, D); } SEAM(1);
    if ((PROBE & 4) && IN(1)) { EpiUp E{(const float*)(ws + OFF_RS0), nullptr, S0}; GEMM(EpiUp, E, xb, D, ws + W_GU1, 2 * FF, D); xcd_barrier(xbar); }
    if ((PROBE & 8) && IN(2)) { EpiRes E{P, 0.5f, 1, xb, P1}; GEMM(EpiRes, E, S0, FF, ws + W_D1, D, FF); xcd_barrier(xbar); }
    if (IN(2)) { EpiRes E{P, 0.5f, 1, xb, P1}; GEMM1K(EpiRes, E, S0, FF, ws + W_D1, FF); gemm_tail<0>(P, lds, S0, FF, (const bf16_t*)(ws + W_D1), FF, 0.5f, 1, xb, P1, nullptr, nullptr, 0); } SEAM(2);
    if (IN(3)) { EpiQkv E{P, P1}; GEMM(EpiQkv, E, xb, D, ws + W_QKV, 3328, D); } SEAM(3);
    const bool dryrt = (P.ph_hi < 1000);
    if ((PROBE & 1) && IN(4)) { phase_prep(P, lds, dryrt); xcd_barrier(xbar); }
    if (IN(4)) { phase_prep(P, lds); } SEAM(4);
    if ((PROBE & 2) && IN(5)) { phase_rec(P, lds, dryrt); xcd_barrier(xbar); }
    if (IN(5)) { phase_rec(P, lds); } SEAM(5);
    if (IN(6)) { EpiSc E{P, P1}; GEMM(EpiSc, E, xb, D, ws + W_SC, 4096, D); } SEAM(6);
    if (IN(7)) { phase_ya(P); } SEAM(7);
    if (IN(8)) { EpiGate E{S3, S3, 0}; GEMM1K(EpiGate, E, S1, D, ws + W_WA, D); gemm_tail<1>(P, lds, S1, D, (const bf16_t*)(ws + W_WA), D, 0.f, 0, nullptr, nullptr, S3, S3, 0); } if (!IN(9)) { SEAM(8); }
    if (IN(9)) { EpiZg E{P, P1}; { pg8::Gemm g{(const bf16_t*)xb, (const bf16_t*)(ws + W_ZG), ROW_SAMPLE, 2048, D, D, D}; pg8::StaticOrder S; S.init(ROW_SAMPLE, 2048, G, cid); pg8::gemm_phase<EpiZg>(lds, g, S, E); }
        gemm_tail<2, 32>(P, lds, xb, D, (const bf16_t*)(ws + W_ZG), D, 0.f, 0, S0, P1, S2, nullptr, 0); } SEAM(9);
    if (IN(10)) { EpiGate E{S3, S0, 1}; GEMM1K(EpiGate, E, S2, D, ws + W_WB, D); gemm_tail<1>(P, lds, S2, D, (const bf16_t*)(ws + W_WB), D, 0.f, 0, nullptr, nullptr, S3, S0, 1); } SEAM(10);
    if (IN(11)) { EpiRes E{P, 1.0f, 0, xb, P2}; GEMM1K(EpiRes, E, S3, D, ws + W_WO, D); gemm_tail<0>(P, lds, S3, D, (const bf16_t*)(ws + W_WO), D, 1.0f, 0, xb, P2, nullptr, nullptr, 0); } SEAM(11);
    if (IN(12)) { EpiUp E{nullptr, P2, S0}; GEMM(EpiUp, E, xb, D, ws + W_GU2, 2 * FF, D); } SEAM(12);
    if (IN(13)) { EpiFinal EF{P.out, P.in[24], ws};
        { pg8::Gemm g{(const bf16_t*)S0, (const bf16_t*)(ws + W_D2), ROW_SAMPLE, D, FF, FF, FF}; pg8::StaticOrder S; S.init(ROW_SAMPLE, D, G, cid);
          if (G == 256) pg8::gemm_phase<EpiFinal, true>(lds, g, S, EF);
          else { EpiRes E{P, 0.5f, 0, nullptr, P3}; pg8::gemm_phase<EpiRes>(lds, g, S, E); } }
        gemm_tail<0>(P, lds, S0, FF, (const bf16_t*)(ws + W_D2), FF, 0.5f, 0, nullptr, P3, nullptr, nullptr, 0); } SEAM(13);
    if (IN(14)) { phase_final(P, G == 256 ? ROW_SAMPLE : 0); }
#undef IN
#undef SEAM
#undef GEMM
#undef GEMM1K
}

extern "C" void kernel_launch(void* const* d_in, const int* in_sizes, int n_in, void* d_out, int out_size, void* d_ws, size_t ws_size, hipStream_t stream) {
    static int grid = 0;
    if (grid == 0) {
        if (n_in != 25 || ws_size < OFF_FINX + 64 * 4 * 256 * 4) { fprintf(stderr, "kernel_launch: unexpected problem (n_in %d, ws %zu)\n", n_in, ws_size); grid = -1; return; }
        int dev = 0, cus = 0, per_cu = 0;
        hipGetDevice(&dev); hipDeviceGetAttribute(&cus, hipDeviceAttributeMultiprocessorCount, dev);
        if (hipFuncSetAttribute((const void*)mega, hipFuncAttributeMaxDynamicSharedMemorySize, LDS_BYTES) != hipSuccess) { fprintf(stderr, "kernel_launch: hipFuncSetAttribute failed\n"); grid = -1; return; }
        if (hipOccupancyMaxActiveBlocksPerMultiprocessor(&per_cu, (const void*)mega, 512, LDS_BYTES) != hipSuccess || per_cu < 1) { fprintf(stderr, "kernel_launch: occupancy query failed (%d)\n", per_cu); (void)hipGetLastError(); per_cu = 1; }
        grid = cus * per_cu;
    }
    if (grid < 0) return;
    Params p{};
    for (int i = 0; i < 25; ++i) p.in[i] = (const float*)d_in[i];
    p.out = (float*)d_out; p.ws = (unsigned char*)d_ws;
#if ONE_LAUNCH
    if (hipMemsetAsync((char*)d_ws + OFF_CTL, 0, CTL_BYTES, stream) != hipSuccess) { fprintf(stderr, "memset failed\n"); return; }
    p.ph_lo = 0; p.ph_hi = NPHASE;
    void* args[] = {&p};
    hipError_t e = hipLaunchCooperativeKernel((const void*)mega, dim3(grid), dim3(512), args, LDS_BYTES, stream);
    if (e != hipSuccess) fprintf(stderr, "cooperative launch failed: %s (grid %d)\n", hipGetErrorString(e), grid);
#else
    for (int k = 0; k < NPHASE; ++k) {
        p.ph_lo = k; p.ph_hi = k + 1;
        hipLaunchKernelGGL(mega, dim3(grid), dim3(512), LDS_BYTES, stream, p);
    }
#endif
}
```
